# Optimizing an MI355X kernel written in HIP

```python
import jax, jax.numpy as jnp
from jax import lax
import numpy as np

D_MODEL = 1024
BATCH = 8
SEQ = 8192
DEPTH = 1

CHUNK = 64
Q_BLOCK = 128
D_MIX = D_MODEL
MLA_HEADS = 4
MLA_NOPE = 128
MLA_ROPE = 64
MLA_V = 128
MLA_WIDTH = MLA_HEADS * MLA_V
Q_LORA = 384
KV_LORA = 256
ROPE_BASE = 10000.0
RWKV_HEAD = 64
RWKV_WIDTH = D_MIX - MLA_WIDTH
RWKV_HEADS = RWKV_WIDTH // RWKV_HEAD
DECAY_LORA = 64
AAA_LORA = 64
GATE_LORA = 128
MLA_COLS = Q_LORA + KV_LORA + MLA_ROPE
RWKV_COLS = 3 * RWKV_WIDTH + DECAY_LORA + AAA_LORA + GATE_LORA
IN_COLS = MLA_COLS + RWKV_COLS
D_FF = 2816
NORM_EPS = 1e-6
GN_EPS = 64e-5
N_MOD = 9

kernel_name = "hybrid_mla_rwkv7_macaron_adaln"


def rmsnorm(x, g, eps=NORM_EPS):
    x32 = x.astype(jnp.float32)
    y = x32 * lax.rsqrt(jnp.mean(x32 * x32, axis=-1, keepdims=True) + eps)
    return (y * g.astype(jnp.float32)).astype(x.dtype)


def modulate(u, shift, scale):
    return u * (1.0 + scale[:, None, :]) + shift[:, None, :]


def swiglu(u, w_gate, w_up, w_down):
    return (jax.nn.silu(u @ w_gate) * (u @ w_up)) @ w_down


def apply_rot(x, cos, sin):
    half = x.shape[-1] // 2
    x32 = x.astype(jnp.float32)
    x1, x2 = x32[..., :half], x32[..., half:]
    return jnp.concatenate([x1 * cos - x2 * sin, x2 * cos + x1 * sin], axis=-1).astype(x.dtype)


def mla_group(p_q, p_kv, p_kr, cos, sin, q_norm_g, w_uq, kv_norm_g, w_ukv):
    B, S, _ = p_q.shape
    q = (rmsnorm(p_q, q_norm_g) @ w_uq).reshape(B, S, MLA_HEADS, MLA_NOPE + MLA_ROPE)
    q_nope = q[..., :MLA_NOPE]
    q_rope = apply_rot(q[..., MLA_NOPE:], cos[:, :, None, :], sin[:, :, None, :])
    kv = (rmsnorm(p_kv, kv_norm_g) @ w_ukv).reshape(B, S, MLA_HEADS, MLA_NOPE + MLA_V)
    k_nope, v = kv[..., :MLA_NOPE], kv[..., MLA_NOPE:]
    k_rope = apply_rot(p_kr, cos, sin)
    nb = S // Q_BLOCK
    qn_b = q_nope.reshape(B, nb, Q_BLOCK, MLA_HEADS, MLA_NOPE).transpose(1, 0, 2, 3, 4)
    qr_b = q_rope.reshape(B, nb, Q_BLOCK, MLA_HEADS, MLA_ROPE).transpose(1, 0, 2, 3, 4)
    key_chunk = jnp.arange(S) // CHUNK
    scale = (MLA_NOPE + MLA_ROPE) ** -0.5

    def block(args):
        qn, qr, i = args
        s = (jnp.einsum('bqhd,bkhd->bhqk', qn, k_nope)
             + jnp.einsum('bqhd,bkd->bhqk', qr, k_rope)).astype(jnp.float32) * scale
        q_chunk = (i * Q_BLOCK + jnp.arange(Q_BLOCK)) // CHUNK
        mask = key_chunk[None, :] <= q_chunk[:, None]
        s = jnp.where(mask[None, None], s, -jnp.inf)
        pr = jax.nn.softmax(s, axis=-1).astype(v.dtype)
        return jnp.einsum('bhqk,bkhd->bqhd', pr, v)

    o = lax.map(block, (qn_b, qr_b, jnp.arange(nb)))
    return o.transpose(1, 0, 2, 3, 4).reshape(B, S, MLA_WIDTH)


def rwkv7_group(p, shift_mix, w0, w2, a0, a2, g2, k_k, k_a, r_k, ln_w, ln_b):
    B, S, _ = p.shape
    C, H, N = RWKV_WIDTH, RWKV_HEADS, RWKV_HEAD
    f32 = jnp.float32
    p_prev = jnp.pad(p, ((0, 0), (1, 0), (0, 0)))[:, :-1]
    p = p + (p_prev - p) * shift_mix
    r, k, v = p[..., :C], p[..., C:2 * C], p[..., 2 * C:3 * C]
    o = 3 * C
    xw = p[..., o:o + DECAY_LORA]
    xa = p[..., o + DECAY_LORA:o + DECAY_LORA + AAA_LORA]
    xg = p[..., o + DECAY_LORA + AAA_LORA:]
    w_log = -jax.nn.softplus(-(w0 + jnp.tanh(xw) @ w2)) - 0.5
    decay = jnp.exp(-jnp.exp(w_log.astype(f32)))
    a = jax.nn.sigmoid(a0 + xa @ a2)
    g = jax.nn.sigmoid(xg) @ g2
    kk = (k * k_k).astype(f32).reshape(B, S, H, N)
    kk = kk / jnp.maximum(jnp.sqrt(jnp.sum(kk * kk, axis=-1, keepdims=True)), 1e-12)
    k = k * (1.0 + (a - 1.0) * k_a)
    heads = lambda t: t.astype(f32).reshape(B, S, H, N)
    r_h, k_h, v_h, a_h = heads(r), heads(k), heads(v), heads(a)
    tm = lambda t: jnp.moveaxis(t.reshape(B, S, H, N), 1, 0)

    def step(state, inp):
        r_t, w_t, k_t, v_t, aa_t, bb_t = inp
        sa = jnp.einsum('bhvk,bhk->bhv', state, aa_t)
        state = (state * w_t[:, :, None, :] + sa[..., None] * bb_t[:, :, None, :]
                 + v_t[..., None] * k_t[:, :, None, :])
        return state, jnp.einsum('bhvk,bhk->bhv', state, r_t)

    s0 = jnp.zeros((B, H, N, N), f32)
    _, y = lax.scan(step, s0, (tm(r_h), tm(decay), tm(k_h), tm(v_h), tm(-kk), tm(kk * a_h)))
    y = jnp.moveaxis(y, 0, 1)
    mu = jnp.mean(y, axis=-1, keepdims=True)
    var = jnp.mean(jnp.square(y - mu), axis=-1, keepdims=True)
    y = ((y - mu) * lax.rsqrt(var + GN_EPS)).reshape(B, S, C) * ln_w.astype(f32) + ln_b.astype(f32)
    bonus = jnp.sum(r_h * k_h * r_k.astype(f32), axis=-1, keepdims=True) * v_h
    out = (y + bonus.reshape(B, S, C)) * g.astype(f32)
    return out.astype(p.dtype)


def setup_inputs(seed: int = 0) -> dict:
    key = jax.random.key(seed)
    ks = iter(jax.random.split(key, 48))
    L, D, C = DEPTH, D_MODEL, RWKV_WIDTH

    def nrm(shape, scale):
        return scale * jax.random.normal(next(ks), shape, jnp.float32)

    def gain(shape):
        return 1.0 + nrm(shape, 0.02)

    def unif(shape, lo, hi):
        return jax.random.uniform(next(ks), shape, jnp.float32, lo, hi)

    x = nrm((BATCH, SEQ, D), 1.0)
    c = nrm((BATCH, D), 1.0)
    offset = jax.random.randint(next(ks), (BATCH, 1), 0, 4096, dtype=jnp.int32)
    positions = offset + jnp.arange(SEQ, dtype=jnp.int32)[None, :]
    return {
        "x": x,
        "c": c,
        "positions": positions,
        "w_mod": nrm((L, D, N_MOD * D), 0.5 * D ** -0.5),
        "b_mod": nrm((L, N_MOD * D), 0.02),
        "ffn1_norm_g": gain((L, D)),
        "ffn1_w_gate": nrm((L, D, D_FF), D ** -0.5),
        "ffn1_w_up": nrm((L, D, D_FF), D ** -0.5),
        "ffn1_w_down": nrm((L, D_FF, D), D_FF ** -0.5),
        "mix_norm_g": gain((L, D)),
        "w_in": nrm((L, D, IN_COLS), D ** -0.5),
        "q_norm_g": gain((L, Q_LORA)),
        "w_uq": nrm((L, Q_LORA, MLA_HEADS * (MLA_NOPE + MLA_ROPE)), Q_LORA ** -0.5),
        "kv_norm_g": gain((L, KV_LORA)),
        "w_ukv": nrm((L, KV_LORA, MLA_HEADS * (MLA_NOPE + MLA_V)), KV_LORA ** -0.5),
        "attn_out_norm_g": gain((L, MLA_WIDTH)),
        "rwkv_shift_mix": unif((L, RWKV_COLS), 0.0, 1.0),
        "rwkv_w0": unif((L, C), -5.5, 0.5),
        "rwkv_w2": nrm((L, DECAY_LORA, C), 0.1 * DECAY_LORA ** -0.5),
        "rwkv_a0": nrm((L, C), 0.1),
        "rwkv_a2": nrm((L, AAA_LORA, C), 0.5 * AAA_LORA ** -0.5),
        "rwkv_g2": nrm((L, GATE_LORA, C), GATE_LORA ** -0.5),
        "rwkv_k_k": 0.85 + nrm((L, C), 0.05),
        "rwkv_k_a": 1.0 + nrm((L, C), 0.05),
        "rwkv_r_k": nrm((L, RWKV_HEADS, RWKV_HEAD), 0.1),
        "rwkv_ln_w": gain((L, C)),
        "rwkv_ln_b": nrm((L, C), 0.02),
        "w_out": nrm((L, D_MIX, D), D_MIX ** -0.5),
        "ffn2_norm_g": gain((L, D)),
        "ffn2_w_gate": nrm((L, D, D_FF), D ** -0.5),
        "ffn2_w_up": nrm((L, D, D_FF), D ** -0.5),
        "ffn2_w_down": nrm((L, D_FF, D), D_FF ** -0.5),
        "final_norm_g": gain((D,)),
    }


def reference(x, c, positions, w_mod, b_mod, ffn1_norm_g, ffn1_w_gate, ffn1_w_up, ffn1_w_down,
              mix_norm_g, w_in, q_norm_g, w_uq, kv_norm_g, w_ukv, attn_out_norm_g,
              rwkv_shift_mix, rwkv_w0, rwkv_w2, rwkv_a0, rwkv_a2, rwkv_g2, rwkv_k_k, rwkv_k_a,
              rwkv_r_k, rwkv_ln_w, rwkv_ln_b, w_out, ffn2_norm_g, ffn2_w_gate, ffn2_w_up,
              ffn2_w_down, final_norm_g):
    half = MLA_ROPE // 2
    inv_freq = ROPE_BASE ** (-jnp.arange(half, dtype=jnp.float32) / half)
    ang = positions.astype(jnp.float32)[..., None] * inv_freq
    cos, sin = jnp.cos(ang), jnp.sin(ang)
    c_act = jax.nn.silu(c)
    h = x
    for l in range(DEPTH):
        mod = c_act @ w_mod[l] + b_mod[l]
        sh1, sc1, gt1, sh2, sc2, gt2, sh3, sc3, gt3 = jnp.split(mod, N_MOD, axis=-1)
        u = modulate(rmsnorm(h, ffn1_norm_g[l]), sh1, sc1)
        h = h + 0.5 * gt1[:, None, :] * swiglu(u, ffn1_w_gate[l], ffn1_w_up[l], ffn1_w_down[l])
        u = modulate(rmsnorm(h, mix_norm_g[l]), sh2, sc2)
        proj = u @ w_in[l]
        p_q = proj[..., :Q_LORA]
        p_kv = proj[..., Q_LORA:Q_LORA + KV_LORA]
        p_kr = proj[..., Q_LORA + KV_LORA:MLA_COLS]
        p_rw = proj[..., MLA_COLS:]
        y_a = mla_group(p_q, p_kv, p_kr, cos, sin, q_norm_g[l], w_uq[l], kv_norm_g[l], w_ukv[l])
        y_a = rmsnorm(y_a, attn_out_norm_g[l])
        y_b = rwkv7_group(p_rw, rwkv_shift_mix[l], rwkv_w0[l], rwkv_w2[l], rwkv_a0[l], rwkv_a2[l],
                          rwkv_g2[l], rwkv_k_k[l], rwkv_k_a[l], rwkv_r_k[l], rwkv_ln_w[l], rwkv_ln_b[l])
        y = jnp.concatenate([y_a, y_b], axis=-1) @ w_out[l]
        h = h + gt2[:, None, :] * y
        u = modulate(rmsnorm(h, ffn2_norm_g[l]), sh3, sc3)
        h = h + 0.5 * gt3[:, None, :] * swiglu(u, ffn2_w_gate[l], ffn2_w_up[l], ffn2_w_down[l])
    return rmsnorm(h, final_norm_g)
```

```cpp
#include <hip/hip_runtime.h>
#include <hip/hip_cooperative_groups.h>
#include <cstdio>
#include <cstdint>
namespace cg = cooperative_groups;
namespace pg8 {
#define PG8_LAS __attribute__((address_space(3)))
typedef unsigned short bf16_t;
typedef short bf16x8 __attribute__((ext_vector_type(8)));
typedef float f32x4 __attribute__((ext_vector_type(4)));
typedef unsigned u32x4 __attribute__((ext_vector_type(4)));
constexpr int BM = 256, BK = 64, HALF = 128, HTB = HALF * BK * 2  , STAGE_BYTES = 8 * HTB, NXCD = 8, WGM = 8;

__host__ __device__ __forceinline__ int lds_byte(int r, int c) { const int st = (r >> 4) * 2 + (c >> 5), rr = r & 15, cc = c & 31, ob = rr * 64 + cc * 2; return st * 1024 + (ob ^ (((ob >> 9) & 1) << 5)); }
__host__ __device__ __forceinline__ void stage_rc(int b, int& R, int& C) { const int st = b / 1024, sb = b % 1024, swz = sb ^ (((sb >> 9) & 1) << 5); R = (st >> 1) * 16 + swz / 64; C = (st & 1) * 32 + (swz % 64) / 2; }
__host__ __device__ __forceinline__ int perm32(int rho) { const int n = rho >> 4, i = rho & 15; return 8 * (i >> 2) + 4 * n + (i & 3); }

struct Unit { int pm, pn; };
struct Gemm { const bf16_t* A; const bf16_t* Bt; int M, N, K; };

struct StaticOrder {
    int nM, nN, nwg, G, c;
    __host__ __device__ void init(int M, int N, int G_, int c_) { nM = M / BM; nN = N / BM; nwg = nM * nN; G = G_; c = c_; }
    __host__ __device__ bool next(int i, Unit& u) const {
        const long L = (long)i * G + c; if (L >= nwg) return false;
        int wgid = (int)L; { const int q = nwg / NXCD, r = nwg % NXCD, xcd = wgid % NXCD, off = wgid / NXCD; wgid = (xcd < r ? xcd * (q + 1) : r * (q + 1) + (xcd - r) * q) + off; }
        const int nig = WGM * nN, gid = wgid / nig, fm = gid * WGM, gsz = (nM - fm) < WGM ? (nM - fm) : WGM;
        u.pm = fm + ((wgid % nig) % gsz); u.pn = (wgid % nig) / gsz; return true;
    }
    __device__ __forceinline__ void a_ready(const Unit&) const {}
    __device__ __forceinline__ void done(const Unit&) const {}
};

__device__ __forceinline__ unsigned cvt_pk_bf16(float lo, float hi) { unsigned r; asm volatile("v_cvt_pk_bf16_f32 %0, %1, %2" : "=v"(r) : "v"(lo), "v"(hi)); return r; }
typedef float f32x2 __attribute__((ext_vector_type(2)));
__device__ __forceinline__ unsigned pkbf(float a, float b) { typedef __bf16 bf2_t __attribute__((ext_vector_type(2))); f32x2 v = {a, b}; return __builtin_bit_cast(unsigned, __builtin_convertvector(v, bf2_t)); }
typedef unsigned u32x2 __attribute__((ext_vector_type(2)));

struct EpiSwiglu {
    static constexpr bool PERM = true, AFTER_DRAIN = false;
    bf16_t* O; int ldo;
    __device__ __forceinline__ void operator()(const f32x4 (&acc)[2][2][4][2], const Unit& u, int wr, int wc, int fr, int fq) const {
        const int row0 = u.pm * BM + wr * 64 + fr, col0 = u.pn * 128 + wc * 32 + 8 * fq;
#pragma unroll
        for (int ai = 0; ai < 2; ++ai)
#pragma unroll
            for (int m = 0; m < 4; ++m) { bf16_t* rowp = O + (size_t)(row0 + ai * HALF + m * 16) * ldo + col0; float v[8];
#pragma unroll
                for (int bj = 0; bj < 2; ++bj) { const f32x4 g = acc[ai][bj][m][0], up = acc[ai][bj][m][1];
#pragma unroll
                    for (int e = 0; e < 4; ++e) v[4 * bj + e] = g[e] * __builtin_amdgcn_rcpf(1.f + __expf(-g[e])) * up[e]; }
                u32x4 w; w.x = pkbf(v[0], v[1]); w.y = pkbf(v[2], v[3]); w.z = pkbf(v[4], v[5]); w.w = pkbf(v[6], v[7]); *(u32x4*)rowp = w; }
    }
};
struct EpiResid {
    static constexpr bool PERM = false, AFTER_DRAIN = false;
    const float* base; float* out; const float* gate; float gs;
    __device__ __forceinline__ void operator()(const f32x4 (&acc)[2][2][4][2], const Unit& u, int wr, int wc, int fr, int fq) const {
        const int b = (u.pm * BM) >> 13; const float* gp = gate + (size_t)b * 9216;
        const int row0 = u.pm * BM + wr * 64 + fr, col0 = u.pn * BM + wc * 32 + 4 * fq;
        f32x4 gv[2][2];
#pragma unroll
        for (int bj = 0; bj < 2; ++bj)
#pragma unroll
            for (int n = 0; n < 2; ++n) gv[bj][n] = *(const f32x4*)(gp + col0 + bj * HALF + n * 16) * gs;
#pragma unroll
        for (int ai = 0; ai < 2; ++ai)
#pragma unroll
            for (int m = 0; m < 4; ++m) { const size_t off = (size_t)(row0 + ai * HALF + m * 16) * 1024 + col0;
#pragma unroll
                for (int bj = 0; bj < 2; ++bj)
#pragma unroll
                    for (int n = 0; n < 2; ++n) { const f32x4 bs = *(const f32x4*)(base + off + bj * HALF + n * 16); *(f32x4*)(out + off + bj * HALF + n * 16) = bs + gv[bj][n] * acc[ai][bj][m][n]; } }
    }
};
__device__ __forceinline__ void store8bf(bf16_t* p, const f32x4 v0, const f32x4 v1) { u32x4 w; w.x = pkbf(v0[0], v0[1]); w.y = pkbf(v0[2], v0[3]); w.z = pkbf(v1[0], v1[1]); w.w = pkbf(v1[2], v1[3]); *(u32x4*)p = w; }
struct EpiPlain {
    static constexpr bool PERM = true, AFTER_DRAIN = false;
    bf16_t* O; int ldc;
    __device__ __forceinline__ void operator()(const f32x4 (&acc)[2][2][4][2], const Unit& u, int wr, int wc, int fr, int fq) const {
        const int row0 = u.pm * BM + wr * 64 + fr, col0 = u.pn * BM + wc * 32 + 8 * fq;
#pragma unroll
        for (int ai = 0; ai < 2; ++ai)
#pragma unroll
            for (int m = 0; m < 4; ++m) { bf16_t* rowp = O + (size_t)(row0 + ai * HALF + m * 16) * ldc + col0;
#pragma unroll
                for (int bj = 0; bj < 2; ++bj) store8bf(rowp + bj * HALF, acc[ai][bj][m][0], acc[ai][bj][m][1]); }
    }
};
struct EpiProj {
    static constexpr bool PERM = true, AFTER_DRAIN = false;
    bf16_t* Pm; bf16_t* Pr;
    __device__ __forceinline__ void operator()(const f32x4 (&acc)[2][2][4][2], const Unit& u, int wr, int wc, int fr, int fq) const {
        bf16_t* bp; int ld, colt; if (u.pn < 3) { bp = Pm; ld = 768; colt = u.pn * BM; } else { bp = Pr; ld = 1792; colt = (u.pn - 3) * BM; }
        const int row0 = u.pm * BM + wr * 64 + fr, col0 = colt + wc * 32 + 8 * fq;
#pragma unroll
        for (int ai = 0; ai < 2; ++ai)
#pragma unroll
            for (int m = 0; m < 4; ++m) { bf16_t* rowp = bp + (size_t)(row0 + ai * HALF + m * 16) * ld + col0;
#pragma unroll
                for (int bj = 0; bj < 2; ++bj) store8bf(rowp + bj * HALF, acc[ai][bj][m][0], acc[ai][bj][m][1]); }
    }
};
struct EpiQ {
    static constexpr bool PERM = true, AFTER_DRAIN = false;
    bf16_t* O; const float* cs; float scale;
    __device__ __forceinline__ void operator()(const f32x4 (&acc)[2][2][4][2], const Unit& u, int wr, int wc, int fr, int fq) const {
        const int row0 = u.pm * BM + wr * 64 + fr, col0 = u.pn * BM + wc * 32 + 8 * fq;
#pragma unroll
        for (int bj = 0; bj < 2; ++bj) { const int c = col0 + bj * HALF, p = c % 192; const bool rope = p >= 128; const int j4 = ((p - 128) >> 3) * 4;
#pragma unroll
            for (int ai = 0; ai < 2; ++ai)
#pragma unroll
                for (int m = 0; m < 4; ++m) { const int row = row0 + ai * HALF + m * 16; f32x4 v0 = acc[ai][bj][m][0], v1 = acc[ai][bj][m][1];
                    if (rope) { const f32x4 cv = *(const f32x4*)(cs + (size_t)row * 64 + j4), sv = *(const f32x4*)(cs + (size_t)row * 64 + 32 + j4);
                        const f32x4 a = v0 * cv - v1 * sv, b2 = v1 * cv + v0 * sv; v0 = a; v1 = b2; }
                    store8bf(O + (size_t)row * 768 + c, v0 * scale, v1 * scale); } }
    }
};
struct EpiVT {
    static constexpr bool PERM = true, AFTER_DRAIN = false;
    bf16_t* O; size_t ldo;
    __device__ __forceinline__ void operator()(const f32x4 (&acc)[2][2][4][2], const Unit& u, int wr, int wc, int fr, int fq) const {
        const int row0 = u.pm * BM + wr * 64 + fr, col0 = u.pn * BM + wc * 32 + 8 * fq;
#pragma unroll
        for (int ai = 0; ai < 2; ++ai)
#pragma unroll
            for (int m = 0; m < 4; ++m) { bf16_t* rowp = O + (size_t)(row0 + ai * HALF + m * 16) * ldo;
#pragma unroll
                for (int bj = 0; bj < 2; ++bj)
#pragma unroll
                    for (int n = 0; n < 2; ++n) { const int c = col0 + bj * HALF + 4 * n, q4 = (c & 15) >> 2, pq = (q4 == 1) ? 2 : ((q4 == 2) ? 1 : q4), dst = (c & ~15) + 4 * pq;
                        const f32x4 v = acc[ai][bj][m][n]; u32x2 w; w.x = pkbf(v[0], v[1]); w.y = pkbf(v[2], v[3]); *(u32x2*)(rowp + dst) = w; } }
    }
};
struct EpiLora {
    static constexpr bool PERM = true, AFTER_DRAIN = false;
    float* DEC; bf16_t* AL; bf16_t* YC; const float* w0; const float* a0;
    __device__ __forceinline__ void operator()(const f32x4 (&acc)[2][2][4][2], const Unit& u, int wr, int wc, int fr, int fq) const {
        const int sect = u.pn >> 1; const int row0 = u.pm * BM + wr * 64 + fr, col0 = (u.pn & 1) * BM + wc * 32 + 8 * fq;
#pragma unroll
        for (int bj = 0; bj < 2; ++bj) { const int c = col0 + bj * HALF;
            f32x4 b0 = {0.f, 0.f, 0.f, 0.f}, b1 = b0;
            if (sect == 0) { b0 = *(const f32x4*)(w0 + c); b1 = *(const f32x4*)(w0 + c + 4); } else if (sect == 1) { b0 = *(const f32x4*)(a0 + c); b1 = *(const f32x4*)(a0 + c + 4); }
#pragma unroll
            for (int ai = 0; ai < 2; ++ai)
#pragma unroll
                for (int m = 0; m < 4; ++m) { const int row = row0 + ai * HALF + m * 16; f32x4 v0 = acc[ai][bj][m][0] + b0, v1 = acc[ai][bj][m][1] + b1;
                    if (sect == 0) {
#pragma unroll
                        for (int e = 0; e < 4; ++e) { { const float z = -v0[e]; const float sp = fmaxf(z, 0.f) + __logf(1.f + __expf(-fabsf(z))); v0[e] = __expf(-__expf(-sp - 0.5f)); }
                                                      { const float z = -v1[e]; const float sp = fmaxf(z, 0.f) + __logf(1.f + __expf(-fabsf(z))); v1[e] = __expf(-__expf(-sp - 0.5f)); } }
                        *(f32x4*)(DEC + (size_t)row * 512 + c) = v0; *(f32x4*)(DEC + (size_t)row * 512 + c + 4) = v1;
                    } else if (sect == 1) {
#pragma unroll
                        for (int e = 0; e < 4; ++e) { v0[e] = __builtin_amdgcn_rcpf(1.f + __expf(-v0[e])); v1[e] = __builtin_amdgcn_rcpf(1.f + __expf(-v1[e])); }
                        store8bf(AL + (size_t)row * 512 + c, v0, v1);
                    } else store8bf(YC + (size_t)row * 1024 + 512 + c, v0, v1);
                } }
    }
};
template <class Epi, class Sched, bool ALIGN_EPI = false, bool SP2 = false>
__device__ __forceinline__ void gemm_phase(PG8_LAS unsigned char* lds, const Gemm g, const Sched& S, const Epi& E) {
    int tid_l = threadIdx.x; asm volatile("" : "+v"(tid_l));
    const int tid = tid_l, wid = __builtin_amdgcn_readfirstlane(tid >> 6), lane = tid & 63, wr = wid >> 2, wc = wid & 3, fr = lane & 15, fq = lane >> 4;
    const int K = g.K, nt = K / BK;
    unsigned voffA[2], voffB[2];
#pragma unroll
    for (int i = 0; i < 2; ++i) { int R, C; stage_rc(tid * 16 + i * 8192, R, C); const int Rb = Epi::PERM ? ((R & ~31) + perm32(R & 31)) : R;
        voffA[i] = (unsigned)(R * K + C) * 2u; voffB[i] = (unsigned)(Rb * K + C) * 2u; }
    const size_t kstep = (size_t)(BK * 2);
    const size_t hstep = (size_t)HALF * K * 2;
    const size_t tstep = 2 * hstep;
    const unsigned ldsw = (unsigned)wid * 1024u;
    const int aoff = lds_byte(wr * 64 + fr, fq * 8), boff = lds_byte(wc * 32 + fr, fq * 8);
#define PG8_SA(b, h) (((b) * 2 + (h)) * HTB)
#define PG8_SB(b, h) ((4 + (b) * 2 + (h)) * HTB)
#define PG8_STAGE(bufoff, gbase, voff) do { _Pragma("unroll") for (int _i = 0; _i < 2; ++_i) \
        __builtin_amdgcn_global_load_lds((const unsigned*)((const char*)(gbase) + (voff)[_i]), (PG8_LAS unsigned*)(lds + (bufoff) + ldsw + _i * 8192), 16, 0, 0); } while (0)
#define PG8_LDA(dst, b, h) do { _Pragma("unroll") for (int m = 0; m < 4; ++m) _Pragma("unroll") for (int k = 0; k < 2; ++k) dst[m][k] = *(const PG8_LAS bf16x8*)(lds + PG8_SA(b, h) + aoff + m * 2048 + k * 1024); } while (0)
#define PG8_LDB(dst, b, h) do { _Pragma("unroll") for (int n = 0; n < 2; ++n) _Pragma("unroll") for (int k = 0; k < 2; ++k) dst[n][k] = *(const PG8_LAS bf16x8*)(lds + PG8_SB(b, h) + boff + n * 2048 + k * 1024); } while (0)
#define PG8_MMA(ai, bj, At, Bt) do { __builtin_amdgcn_s_setprio(1); _Pragma("unroll") for (int m = 0; m < 4; ++m) _Pragma("unroll") for (int n = 0; n < 2; ++n) _Pragma("unroll") for (int k = 0; k < 2; ++k) \
        acc[ai][bj][m][n] = __builtin_amdgcn_mfma_f32_16x16x32_bf16(Bt[n][k], At[m][k], acc[ai][bj][m][n], 0, 0, 0); __builtin_amdgcn_s_setprio(0); } while (0)
#define PG8_WAIT_V(n) asm volatile("s_waitcnt vmcnt(" #n ")" ::: "memory")
#define PG8_WAIT_L(n) asm volatile("s_waitcnt lgkmcnt(" #n ")" ::: "memory")
#define PG8_BAR __builtin_amdgcn_s_barrier()
#define PG8_SCHED __builtin_amdgcn_sched_barrier(0)
    Unit cur, nxt; int ui = 0;
    if (!S.next(0, cur)) return;
    f32x4 acc[2][2][4][2];
#pragma unroll
    for (int a = 0; a < 2; ++a)
#pragma unroll
        for (int b = 0; b < 2; ++b)
#pragma unroll
            for (int m = 0; m < 4; ++m)
#pragma unroll
                for (int n = 0; n < 2; ++n) acc[a][b][m][n] = (f32x4){0.f, 0.f, 0.f, 0.f};
    bf16x8 At[4][2], B0[2][2], B1[2][2];
    const char* cA = (const char*)g.A + (size_t)cur.pm * tstep; const char* cB = (const char*)g.Bt + (size_t)cur.pn * tstep;
    S.a_ready(cur);
    if constexpr (SP2) {
        PG8_STAGE(PG8_SB(0, 0), cB, voffB); PG8_STAGE(PG8_SB(0, 1), cB + hstep, voffB); PG8_STAGE(PG8_SA(0, 0), cA, voffA); PG8_STAGE(PG8_SA(0, 1), cA + hstep, voffA);
        if (wr == 1) PG8_BAR;
        PG8_WAIT_V(2); PG8_BAR;
        PG8_STAGE(PG8_SB(1, 0), cB + kstep, voffB); PG8_STAGE(PG8_SA(1, 0), cA + kstep, voffA); PG8_STAGE(PG8_SB(1, 1), cB + hstep + kstep, voffB);
        PG8_WAIT_V(6); PG8_BAR;
    } else {
        PG8_STAGE(PG8_SB(0, 0), cB, voffB); PG8_STAGE(PG8_SA(0, 0), cA, voffA); PG8_STAGE(PG8_SB(0, 1), cB + hstep, voffB); PG8_STAGE(PG8_SA(0, 1), cA + hstep, voffA);
        if (wr == 1) PG8_BAR;
        PG8_WAIT_V(4); PG8_BAR;
        PG8_STAGE(PG8_SB(1, 0), cB + kstep, voffB); PG8_STAGE(PG8_SA(1, 0), cA + kstep, voffA); PG8_STAGE(PG8_SB(1, 1), cB + hstep + kstep, voffB);
        PG8_WAIT_V(6); PG8_BAR;
    }
    for (;;) {
        const bool has_next = S.next(ui + 1, nxt);
        const char* nA = has_next ? (const char*)g.A + (size_t)nxt.pm * tstep : cA; const char* nB = has_next ? (const char*)g.Bt + (size_t)nxt.pn * tstep : cB;
        for (int t = 0; t < nt; t += 2) {
            const bool last = (t == nt - 2);
            const char* a1 = cA + (size_t)(t + 1) * kstep;
            const char* a2 = last ? nA : cA + (size_t)(t + 2) * kstep; const char* b2 = last ? nB : cB + (size_t)(t + 2) * kstep;
            const char* a3 = a2 + kstep; const char* b3 = b2 + kstep;
            if (last && has_next) S.a_ready(nxt);
            if constexpr (SP2) {
            PG8_LDB(B0, 0, 0); PG8_LDB(B1, 0, 1); PG8_SCHED; PG8_LDA(At, 0, 0); PG8_STAGE(PG8_SA(1, 1), a1 + hstep, voffA);
            PG8_WAIT_V(8); PG8_WAIT_L(0); PG8_BAR; PG8_MMA(0, 0, At, B0); PG8_MMA(0, 1, At, B1); PG8_BAR; PG8_SCHED;
            PG8_LDA(At, 0, 1); PG8_STAGE(PG8_SB(0, 0), b2, voffB); PG8_STAGE(PG8_SB(0, 1), b2 + hstep, voffB); PG8_STAGE(PG8_SA(0, 0), a2, voffA);
            PG8_WAIT_V(8); PG8_WAIT_L(0); PG8_BAR; PG8_MMA(1, 0, At, B0); PG8_MMA(1, 1, At, B1); PG8_BAR; PG8_SCHED;
            PG8_LDB(B0, 1, 0); PG8_LDB(B1, 1, 1); PG8_SCHED; PG8_LDA(At, 1, 0); PG8_STAGE(PG8_SA(0, 1), a2 + hstep, voffA);
            PG8_WAIT_V(8); PG8_WAIT_L(0); PG8_BAR; PG8_MMA(0, 0, At, B0); PG8_MMA(0, 1, At, B1); PG8_BAR; PG8_SCHED;
            PG8_LDA(At, 1, 1); PG8_STAGE(PG8_SB(1, 0), b3, voffB); PG8_STAGE(PG8_SB(1, 1), b3 + hstep, voffB); PG8_STAGE(PG8_SA(1, 0), a3, voffA);
            PG8_WAIT_V(8); PG8_WAIT_L(0); PG8_BAR; PG8_MMA(1, 0, At, B0); PG8_MMA(1, 1, At, B1); PG8_BAR; PG8_SCHED;
            } else {
            PG8_LDB(B0, 0, 0); PG8_SCHED; PG8_LDA(At, 0, 0); PG8_STAGE(PG8_SA(1, 1), a1 + hstep, voffA);
            PG8_WAIT_L(8); PG8_BAR; PG8_WAIT_L(0); PG8_MMA(0, 0, At, B0); PG8_BAR; PG8_SCHED;
            PG8_LDB(B1, 0, 1); PG8_STAGE(PG8_SB(0, 0), b2, voffB);
            PG8_BAR; PG8_WAIT_L(0); PG8_MMA(0, 1, At, B1); PG8_BAR;
            PG8_LDA(At, 0, 1); PG8_STAGE(PG8_SA(0, 0), a2, voffA);
            PG8_BAR; PG8_WAIT_L(0); PG8_MMA(1, 0, At, B0); PG8_BAR; PG8_SCHED;
            PG8_STAGE(PG8_SB(0, 1), b2 + hstep, voffB);
            PG8_WAIT_V(6); PG8_BAR; PG8_MMA(1, 1, At, B1); PG8_BAR;
            PG8_LDB(B0, 1, 0); PG8_SCHED; PG8_LDA(At, 1, 0); PG8_STAGE(PG8_SA(0, 1), a2 + hstep, voffA);
            PG8_WAIT_L(8); PG8_BAR; PG8_WAIT_L(0); PG8_MMA(0, 0, At, B0); PG8_BAR; PG8_SCHED;
            PG8_LDB(B1, 1, 1); PG8_STAGE(PG8_SB(1, 0), b3, voffB);
            PG8_BAR; PG8_WAIT_L(0); PG8_MMA(0, 1, At, B1); PG8_BAR;
            PG8_LDA(At, 1, 1); PG8_STAGE(PG8_SA(1, 0), a3, voffA);
            PG8_BAR; PG8_WAIT_L(0); PG8_MMA(1, 0, At, B0); PG8_BAR; PG8_SCHED;
            PG8_STAGE(PG8_SB(1, 1), b3 + hstep, voffB);
            PG8_WAIT_V(6); PG8_BAR; PG8_MMA(1, 1, At, B1); PG8_BAR;
            }
        }
        if constexpr (ALIGN_EPI) { if (wr == 0) PG8_BAR; }
        if constexpr (!Epi::AFTER_DRAIN) { E(acc, cur, wr, wc, fr, fq); S.done(cur); }
        if (!has_next) break;
#pragma unroll
        for (int a = 0; a < 2; ++a)
#pragma unroll
            for (int b = 0; b < 2; ++b)
#pragma unroll
                for (int m = 0; m < 4; ++m)
#pragma unroll
                    for (int n = 0; n < 2; ++n) acc[a][b][m][n] = (f32x4){0.f, 0.f, 0.f, 0.f};
        cur = nxt; cA = nA; cB = nB; ++ui;
        if constexpr (ALIGN_EPI) { if (wr == 1) PG8_BAR; }
    }
    PG8_WAIT_V(0);
    if constexpr (!ALIGN_EPI) { if (wr == 0) PG8_BAR; }
    PG8_BAR;
    if constexpr (Epi::AFTER_DRAIN) { E.fused(acc, cur, wr, wc, fr, fq, lds, wid, lane); S.done(cur); }
#undef PG8_SA
#undef PG8_SB
#undef PG8_STAGE
#undef PG8_LDA
#undef PG8_LDB
#undef PG8_MMA
#undef PG8_WAIT_V
#undef PG8_WAIT_L
#undef PG8_BAR
#undef PG8_SCHED
}
}
#define LAS __attribute__((address_space(3)))
typedef unsigned short bf16;
typedef float f32x4 __attribute__((ext_vector_type(4)));
typedef float f32x2 __attribute__((ext_vector_type(2)));
typedef float f32x16 __attribute__((ext_vector_type(16)));
typedef short bf16x8 __attribute__((ext_vector_type(8)));
typedef unsigned u32x4 __attribute__((ext_vector_type(4)));
typedef unsigned u32x2 __attribute__((ext_vector_type(2)));
constexpr int NB = 8, SEQ = 8192, DM = 1024, MT = NB * SEQ, FF = 2816, NMODC = 9216;
constexpr int RW_T = 128, RW_NC = SEQ / RW_T;
constexpr int LDS_BYTES = 147456;
constexpr size_t MiB = 1u << 20;
constexpr size_t WS_MOD = 0, WS_CTR = 1024 * 1024, WS_BAR = 1024 * 1024 + 65536;
constexpr size_t WS_WGU1 = 2 * MiB, WS_WD1 = 13 * MiB, WS_WIN = 19 * MiB, WS_WUQ = 24 * MiB, WS_WK = 25 * MiB, WS_WV = 25 * MiB + 512 * 1024, WS_WLORA = 26 * MiB, WS_WOUT = 27 * MiB, WS_WGU2 = 29 * MiB, WS_WD2 = 40 * MiB;
constexpr size_t WS_U = 50 * MiB;
constexpr size_t WS_ACT = 178 * MiB;
constexpr size_t WS_QN = 178 * MiB, WS_KVN = 226 * MiB, WS_LIN = 258 * MiB, WS_CS = 290 * MiB, WS_KR = 306 * MiB, WS_QB = 314 * MiB, WS_KN = 410 * MiB, WS_VT = 474 * MiB;
constexpr size_t WS_PRW = 538 * MiB, WS_PMLA = 762 * MiB, WS_DEC = 858 * MiB;
constexpr size_t WS_YB = 858 * MiB  , WS_CT = 986 * MiB;
constexpr size_t WS_G = 178 * MiB, WS_J = 242 * MiB, WS_SST = 314 * MiB, WS_AL = 762 * MiB;

__device__ __forceinline__ float bf2f(unsigned h) { return __uint_as_float(h << 16); }
__device__ __forceinline__ unsigned pk2(float a, float b) { typedef __bf16 bf2_t __attribute__((ext_vector_type(2))); f32x2 v = {a, b}; return __builtin_bit_cast(unsigned, __builtin_convertvector(v, bf2_t)); }
__device__ __forceinline__ float wave_sum(float v) {
#pragma unroll
    for (int o = 1; o < 64; o <<= 1) v += __shfl_xor(v, o);
    return v;
}
__device__ __forceinline__ void unpack8(const u32x4 w, float* f) { f[0] = bf2f(w.x & 0xffffu); f[1] = bf2f(w.x >> 16); f[2] = bf2f(w.y & 0xffffu); f[3] = bf2f(w.y >> 16); f[4] = bf2f(w.z & 0xffffu); f[5] = bf2f(w.z >> 16); f[6] = bf2f(w.w & 0xffffu); f[7] = bf2f(w.w >> 16); }

struct Args { const void* in[33]; float* out; unsigned char* ws; };

__device__ __forceinline__ const float* wsrc(const Args& a, int job, int p, int& ldw) {
    switch (job) {
    case 0: case 6: { const int pn = p >> 8, r = p & 255, bj = r >> 7, wc = (r >> 5) & 3, fq = (r >> 3) & 3, n = (r >> 2) & 1, e = r & 3; ldw = FF; const float* g = (const float*)a.in[job == 0 ? 6 : 29]; const float* u = (const float*)a.in[job == 0 ? 7 : 30]; return (n ? u : g) + 128 * pn + 32 * wc + 8 * fq + 4 * bj + e; }
    case 1: ldw = DM; return (const float*)a.in[8] + p;
    case 7: ldw = DM; return (const float*)a.in[31] + p;
    case 2: ldw = 2496; return p < 704 ? (const float*)a.in[10] + p : (p < 768 ? nullptr : (const float*)a.in[10] + (p - 64));
    case 3: { ldw = 768; const int h = p / 192, pp = p % 192; if (pp < 128) return (const float*)a.in[12] + h * 192 + pp; const int q = pp - 128, j = q >> 3, e = q & 7; const int dim = e < 4 ? 4 * j + e : 32 + 4 * j + (e - 4); return (const float*)a.in[12] + h * 192 + 128 + dim; }
    case 4: ldw = 1024; return (const float*)a.in[14] + (p >> 7) * 256 + (p & 127);
    case 5: ldw = 1024; return (const float*)a.in[14] + (p >> 7) * 256 + 128 + (p & 127);
    default: ldw = DM; return (const float*)a.in[27] + p;
    }
}
__device__ __forceinline__ void p0_transpose_item(const Args& a, int job, int K, int nblk, bf16* WT, LAS float* scr, int item, int lane) {
    const int kb = item / nblk, nb = item % nblk, k0 = 64 * kb, n0 = 32 * nb;
    int ldw; const float* src = wsrc(a, job, n0 + (lane & 31), ldw);
    float tv[32];
#pragma unroll
    for (int i = 0; i < 32; ++i) { const int kk = 2 * i + (lane >> 5); tv[i] = src ? src[(size_t)(k0 + kk) * ldw] : 0.f; }
#pragma unroll
    for (int i = 0; i < 32; ++i) { const int kk = 2 * i + (lane >> 5); scr[kk * 33 + (lane & 31)] = tv[i]; }
    asm volatile("s_waitcnt lgkmcnt(0)" ::: "memory");
    const int c = lane & 7;
#pragma unroll
    for (int j = 0; j < 4; ++j) { const int n = (lane >> 3) + 8 * j; const LAS float* s = scr + (8 * c) * 33 + n;
        u32x4 o; o.x = pk2(s[0 * 33], s[1 * 33]); o.y = pk2(s[2 * 33], s[3 * 33]); o.z = pk2(s[4 * 33], s[5 * 33]); o.w = pk2(s[6 * 33], s[7 * 33]);
        *(u32x4*)(WT + (size_t)(n0 + n) * K + k0 + 8 * c) = o; }
    asm volatile("s_waitcnt lgkmcnt(0)" ::: "memory");
}
__device__ __forceinline__ void phase_prologue(const Args& a, LAS unsigned char* lds, int tid, int lane, int wave) {
    unsigned char* ws = a.ws;
    __syncthreads();
    if (blockIdx.x < NMODC / 64) {
        LAS float* cact = (LAS float*)lds; LAS float* red = (LAS float*)(lds + 32768);
        const float* c = (const float*)a.in[1];
        for (int i = tid; i < NB * DM; i += 512) { const float v = c[i]; cact[i] = v / (1.f + __expf(-v)); }
        __syncthreads();
        const float* wm = (const float*)a.in[3]; const int col = blockIdx.x * 64 + lane; float acc[NB];
#pragma unroll
        for (int b = 0; b < NB; ++b) acc[b] = 0.f;
        for (int k0 = wave * 128; k0 < wave * 128 + 128; k0 += 16) { float wv[16];
#pragma unroll
            for (int i = 0; i < 16; ++i) wv[i] = wm[(size_t)(k0 + i) * NMODC + col];
#pragma unroll
            for (int i = 0; i < 16; ++i)
#pragma unroll
                for (int b = 0; b < NB; ++b) acc[b] += cact[b * DM + k0 + i] * wv[i]; }
#pragma unroll
        for (int b = 0; b < NB; ++b) red[(wave * NB + b) * 64 + lane] = acc[b];
        __syncthreads();
        { float s = ((const float*)a.in[4])[col];
#pragma unroll
          for (int w = 0; w < 8; ++w) s += red[(w * NB + wave) * 64 + lane];
          ((float*)(ws + WS_MOD))[(size_t)wave * NMODC + col] = s; }
        __syncthreads();
    }
    const int NMW = NMODC / 64;
    const bool split = (int)gridDim.x >= NMW + 96;
    const int gw = split ? ((int)blockIdx.x - NMW) * 8 + wave : (int)blockIdx.x * 8 + wave, NGW = split ? ((int)gridDim.x - NMW) * 8 : (int)gridDim.x * 8;
    LAS float* scr = (LAS float*)(lds + wave * 16384);
    const int jobK[9] = {DM, FF, DM, 384, 256, 256, DM, FF, DM};
    const int jobN[9] = {2 * FF, DM, 2560, 768, 512, 512, 2 * FF, DM, DM};
    const size_t jobO[9] = {WS_WGU1, WS_WD1, WS_WIN, WS_WUQ, WS_WK, WS_WV, WS_WGU2, WS_WD2, WS_WOUT};
#pragma unroll
    for (int j = 0; j < 9; ++j) { const int K = jobK[j], nblk = jobN[j] / 32, nit = (K / 64) * nblk;
        if (gw >= 0) for (int it = gw; it < nit; it += NGW) p0_transpose_item(a, j, K, nblk, (bf16*)(ws + jobO[j]), scr, it, lane); }
    { bf16* WL = (bf16*)(ws + WS_WLORA); const float* w2 = (const float*)a.in[18]; const float* a2 = (const float*)a.in[20]; const float* g2 = (const float*)a.in[21];
      if (gw >= 0) for (int i = gw * 64 + lane; i < 1536 * 256; i += NGW * 64) { const int c = i >> 8, k = i & 255; float v = 0.f;
          if (c < 512) { if (k < 64) v = w2[k * 512 + c]; } else if (c < 1024) { if (k >= 64 && k < 128) v = a2[(k - 64) * 512 + (c - 512)]; } else { if (k >= 128) v = g2[(k - 128) * 512 + (c - 1024)]; }
          WL[i] = (bf16)(pk2(v, 0.f) & 0xffffu); } }
}

__device__ __forceinline__ void phase_normmod(const float* X, const float* g, const float* mod, int sh_off, int sc_off, bf16* U, int lane, int gw, int NGW, int rowEnd = MT) {
#pragma unroll 1
    for (int row = gw; row < rowEnd; row += 2 * NGW) { const int row2 = row + NGW;
        const bool has2 = row2 < rowEnd; const int rB = has2 ? row2 : row;
        const f32x4* xa = (const f32x4*)(X + (size_t)row * DM) + lane; const f32x4* xb = (const f32x4*)(X + (size_t)rB * DM) + lane; f32x4 va[4], vb[4]; float sa = 0.f, sb = 0.f;
#pragma unroll
        for (int j = 0; j < 4; ++j) { va[j] = xa[64 * j]; vb[j] = xb[64 * j]; }
#pragma unroll
        for (int j = 0; j < 4; ++j) { sa += (va[j].x * va[j].x + va[j].y * va[j].y) + (va[j].z * va[j].z + va[j].w * va[j].w); sb += (vb[j].x * vb[j].x + vb[j].y * vb[j].y) + (vb[j].z * vb[j].z + vb[j].w * vb[j].w); }
#pragma unroll
        for (int o = 1; o < 64; o <<= 1) { sa += __shfl_xor(sa, o); sb += __shfl_xor(sb, o); }
        const float ra = rsqrtf(sa * (1.f / DM) + 1e-6f), rb = rsqrtf(sb * (1.f / DM) + 1e-6f);
        const float* ma = mod + (size_t)(row >> 13) * NMODC; const float* mb = mod + (size_t)(rB >> 13) * NMODC;
#pragma unroll
        for (int j = 0; j < 4; ++j) { const int col = 4 * lane + 256 * j; const f32x4 gv = *(const f32x4*)(g + col);
            { const f32x4 sc = *(const f32x4*)(ma + sc_off + col), sh = *(const f32x4*)(ma + sh_off + col); const f32x4 o = (va[j] * ra * gv) * (sc + 1.f) + sh; u32x2 w; w.x = pk2(o.x, o.y); w.y = pk2(o.z, o.w); *(u32x2*)(U + (size_t)row * DM + col) = w; }
            if (has2) { const f32x4 sc = *(const f32x4*)(mb + sc_off + col), sh = *(const f32x4*)(mb + sh_off + col); const f32x4 o = (vb[j] * rb * gv) * (sc + 1.f) + sh; u32x2 w; w.x = pk2(o.x, o.y); w.y = pk2(o.z, o.w); *(u32x2*)(U + (size_t)rB * DM + col) = w; } }
    }
}
__device__ __forceinline__ void phase_finalnorm(float* X, const float* g, int lane, int gw, int NGW, int rowEnd = MT) {
#pragma unroll 1
    for (int row = gw; row < rowEnd; row += 2 * NGW) { const int row2 = row + NGW; const bool has2 = row2 < rowEnd; const int rB = has2 ? row2 : row;
        f32x4* xa = (f32x4*)(X + (size_t)row * DM) + lane; f32x4* xb = (f32x4*)(X + (size_t)rB * DM) + lane; f32x4 va[4], vb[4]; float sa = 0.f, sb = 0.f;
#pragma unroll
        for (int j = 0; j < 4; ++j) { va[j] = xa[64 * j]; vb[j] = xb[64 * j]; }
#pragma unroll
        for (int j = 0; j < 4; ++j) { sa += (va[j].x * va[j].x + va[j].y * va[j].y) + (va[j].z * va[j].z + va[j].w * va[j].w); sb += (vb[j].x * vb[j].x + vb[j].y * vb[j].y) + (vb[j].z * vb[j].z + vb[j].w * vb[j].w); }
#pragma unroll
        for (int o = 1; o < 64; o <<= 1) { sa += __shfl_xor(sa, o); sb += __shfl_xor(sb, o); }
        const float ra = rsqrtf(sa * (1.f / DM) + 1e-6f), rb = rsqrtf(sb * (1.f / DM) + 1e-6f);
#pragma unroll
        for (int j = 0; j < 4; ++j) { const f32x4 gv = *(const f32x4*)(g + 4 * lane + 256 * j); xa[64 * j] = va[j] * ra * gv; if (has2) xb[64 * j] = vb[j] * rb * gv; }
    }
}
__device__ __forceinline__ void sincos_acc(float a, float& s, float& c) {
    const double ad = (double)a; const double k = rint(ad * 0.63661977236758134308); const float r = (float)(ad - k * 1.57079632679489661923); const float r2 = r * r;
    const float sp = r * (1.f + r2 * (-1.6666666667e-1f + r2 * (8.3333333333e-3f + r2 * (-1.9841269841e-4f + r2 * 2.7557319224e-6f))));
    const float cp = 1.f + r2 * (-0.5f + r2 * (4.1666666667e-2f + r2 * (-1.3888888889e-3f + r2 * (2.4801587302e-5f + r2 * (-2.7557319224e-7f)))));
    const int q = ((int)k) & 3;
    s = (q == 0) ? sp : ((q == 1) ? cp : ((q == 2) ? -sp : -cp));
    c = (q == 0) ? cp : ((q == 1) ? -sp : ((q == 2) ? -cp : sp));
}
struct MixIn { unsigned q[3], kvw[2]; unsigned short x1, x2; int pos; u32x4 kc, kp; u32x2 lc, lp; };
__device__ __forceinline__ void mixprep_load(MixIn& m, const bf16* PM, const bf16* PR, const int* pos, int row, int lane) {
    const bf16* pm = PM + (size_t)row * 768; const int ri = lane & 31;
#pragma unroll
    for (int j = 0; j < 3; ++j) m.q[j] = *(const unsigned*)(pm + 2 * lane + 128 * j);
#pragma unroll
    for (int j = 0; j < 2; ++j) m.kvw[j] = *(const unsigned*)(pm + 384 + 2 * lane + 128 * j);
    m.x1 = pm[640 + ri]; m.x2 = pm[672 + ri]; m.pos = pos[row];
    const bool hp = (row & (SEQ - 1)) != 0; const size_t rp = hp ? (size_t)(row - 1) : (size_t)row;
    m.kc = *(const u32x4*)(PR + (size_t)row * 1792 + 512 + 8 * lane); m.kp = *(const u32x4*)(PR + rp * 1792 + 512 + 8 * lane);
    m.lc = *(const u32x2*)(PR + (size_t)row * 1792 + 1536 + 4 * lane); m.lp = *(const u32x2*)(PR + rp * 1792 + 1536 + 4 * lane);
    if (!hp) { m.kp = (u32x4){0u, 0u, 0u, 0u}; m.lp = (u32x2){0u, 0u}; }
}
__device__ __forceinline__ void mixprep_compute(const MixIn& m, const Args& a, int row, int lane, float invf) {
    unsigned char* ws = a.ws;
    bf16* QN = (bf16*)(ws + WS_QN); bf16* KVN = (bf16*)(ws + WS_KVN); bf16* KR = (bf16*)(ws + WS_KR); bf16* LIN = (bf16*)(ws + WS_LIN); float* CS = (float*)(ws + WS_CS);
    const float* qg = (const float*)a.in[11]; const float* kvg = (const float*)a.in[13]; const float* mix = (const float*)a.in[16] + 1536; const int ri = lane & 31;
    float q[6], kq[4]; float s = 0.f, s2 = 0.f;
#pragma unroll
    for (int j = 0; j < 3; ++j) { q[2 * j] = bf2f(m.q[j] & 0xffffu); q[2 * j + 1] = bf2f(m.q[j] >> 16); s += q[2 * j] * q[2 * j] + q[2 * j + 1] * q[2 * j + 1]; }
#pragma unroll
    for (int j = 0; j < 2; ++j) { kq[2 * j] = bf2f(m.kvw[j] & 0xffffu); kq[2 * j + 1] = bf2f(m.kvw[j] >> 16); s2 += kq[2 * j] * kq[2 * j] + kq[2 * j + 1] * kq[2 * j + 1]; }
    float kc[8], kp[8]; unpack8(m.kc, kc); unpack8(m.kp, kp);
    const float* mk = (const float*)a.in[16] + 512 + 8 * lane; const float* kkp = (const float*)a.in[22] + 8 * lane; float ss = 0.f;
#pragma unroll
    for (int e = 0; e < 8; ++e) { const float kx = (kc[e] + (kp[e] - kc[e]) * mk[e]) * kkp[e]; ss += kx * kx; }
#pragma unroll
    for (int o = 1; o < 64; o <<= 1) { s += __shfl_xor(s, o); s2 += __shfl_xor(s2, o); if (o < 8) ss += __shfl_xor(ss, o); }
    const float rinv = rsqrtf(s * (1.f / 384.f) + 1e-6f), rinv2 = rsqrtf(s2 * (1.f / 256.f) + 1e-6f);
#pragma unroll
    for (int j = 0; j < 3; ++j) { const int col = 2 * lane + 128 * j; *(unsigned*)(QN + (size_t)row * 384 + col) = pk2(q[2 * j] * rinv * qg[col], q[2 * j + 1] * rinv * qg[col + 1]); }
#pragma unroll
    for (int j = 0; j < 2; ++j) { const int col = 2 * lane + 128 * j; *(unsigned*)(KVN + (size_t)row * 256 + col) = pk2(kq[2 * j] * rinv2 * kvg[col], kq[2 * j + 1] * rinv2 * kvg[col + 1]); }
    if ((lane & 7) == 0) ((float*)(ws + WS_CT))[(size_t)row * 8 + (lane >> 3)] = 1.f / fmaxf(sqrtf(ss), 1e-12f);
    { const float ang = (float)m.pos * invf; float sn, cn; sincos_acc(ang, sn, cn);
      const float x1 = bf2f(m.x1), x2 = bf2f(m.x2);
      if (lane < 32) { CS[(size_t)row * 64 + ri] = cn; CS[(size_t)row * 64 + 32 + ri] = sn;
          const unsigned o = pk2(x1 * cn - x2 * sn, x2 * cn + x1 * sn);
          KR[(size_t)row * 64 + 8 * (ri >> 2) + (ri & 3)] = (bf16)(o & 0xffffu); KR[(size_t)row * 64 + 8 * (ri >> 2) + 4 + (ri & 3)] = (bf16)(o >> 16); } }
    { const f32x4 mx = *(const f32x4*)(mix + 4 * lane);
      float cu[4] = {bf2f(m.lc.x & 0xffffu), bf2f(m.lc.x >> 16), bf2f(m.lc.y & 0xffffu), bf2f(m.lc.y >> 16)}; const float pv[4] = {bf2f(m.lp.x & 0xffffu), bf2f(m.lp.x >> 16), bf2f(m.lp.y & 0xffffu), bf2f(m.lp.y >> 16)};
#pragma unroll
      for (int e = 0; e < 4; ++e) { float p = cu[e] + (pv[e] - cu[e]) * mx[e];
          if (lane < 16) p = 1.f - 2.f / (1.f + __expf(2.f * p)); else if (lane >= 32) p = 1.f / (1.f + __expf(-p));
          cu[e] = p; }
      u32x2 w; w.x = pk2(cu[0], cu[1]); w.y = pk2(cu[2], cu[3]); *(u32x2*)(LIN + (size_t)row * 256 + 4 * lane) = w; }
}
__device__ __forceinline__ void phase_mixprep(const Args& a, int lane, int gw, int NGW, int rowEnd = MT) {
    unsigned char* ws = a.ws;
    const bf16* PM = (const bf16*)(ws + WS_PMLA); const bf16* PR = (const bf16*)(ws + WS_PRW); const int* pos = (const int*)a.in[2];
    const float invf = powf(10000.0f, -(float)(lane & 31) / 32.0f);
#pragma unroll 1
    for (int row = gw; row < rowEnd; row += 2 * NGW) { const int row2 = row + NGW; const bool has2 = row2 < rowEnd;
        MixIn A, B; mixprep_load(A, PM, PR, pos, row, lane); mixprep_load(B, PM, PR, pos, has2 ? row2 : row, lane);
        mixprep_compute(A, a, row, lane, invf); if (has2) mixprep_compute(B, a, row2, lane, invf); }
}
__device__ __forceinline__ void phase_yanorm(bf16* YC, const float* g, int lane, int gw, int NGW) {
    for (int row = gw; row < MT; row += NGW) { u32x4* p = (u32x4*)(YC + (size_t)row * DM + 8 * lane); float f[8]; unpack8(*p, f); float s = 0.f;
#pragma unroll
        for (int e = 0; e < 8; ++e) s += f[e] * f[e];
        const float rinv = rsqrtf(wave_sum(s) * (1.f / 512.f) + 1e-6f); const f32x4 g0 = *(const f32x4*)(g + 8 * lane), g1 = *(const f32x4*)(g + 8 * lane + 4);
        u32x4 o; o.x = pk2(f[0] * rinv * g0.x, f[1] * rinv * g0.y); o.y = pk2(f[2] * rinv * g0.z, f[3] * rinv * g0.w); o.z = pk2(f[4] * rinv * g1.x, f[5] * rinv * g1.y); o.w = pk2(f[6] * rinv * g1.z, f[7] * rinv * g1.w); *p = o; }
}

constexpr int AT_KSTR = 400, AT_VSTR = 144, AT_KB = 64 * AT_KSTR, AT_VB = 128 * AT_VSTR, AT_STAGE = AT_KB + AT_VB;
__device__ __forceinline__ void attn_unit(const bf16* QB, const bf16* KN, const bf16* KR, const bf16* VT, bf16* YC, LAS unsigned char* lds, int b, int h, int u, int tid, int lane, int wave) {
    const int r32 = lane & 31, hi = lane >> 5;
    const int q0 = u * 256 + wave * 32; const size_t tokq = (size_t)b * SEQ + q0 + r32;
    const int nt_unit = 4 * u + 4, nt_wave = 4 * u + (wave >> 1) + 1;
    bf16x8 qf[12];
#pragma unroll
    for (int ks = 0; ks < 12; ++ks) qf[ks] = *(const bf16x8*)(QB + tokq * 768 + h * 192 + 16 * ks + 8 * hi);
    f32x16 ot[4];
#pragma unroll
    for (int d = 0; d < 4; ++d)
#pragma unroll
        for (int i = 0; i < 16; ++i) ot[d][i] = 0.f;
    float m_run = -INFINITY, l_run = 0.f;
    unsigned knoff[2], vtoff[2]; int kndst[2], vtdst[2];
#pragma unroll
    for (int i = 0; i < 2; ++i) { const int c = tid + 512 * i; { const int row = c >> 4, cc = c & 15; knoff[i] = (unsigned)((b * SEQ + row) * 512 + h * 128 + cc * 8); kndst[i] = row * AT_KSTR + cc * 16; }
        { const int row = c >> 3, cc = c & 7; vtoff[i] = (unsigned)((h * 128 + row) * MT + b * SEQ + cc * 8); vtdst[i] = AT_KB + row * AT_VSTR + cc * 16; } }
    const unsigned kroff = (unsigned)((b * SEQ + (tid >> 3)) * 64 + (tid & 7) * 8); const int krdst = (tid >> 3) * AT_KSTR + 256 + (tid & 7) * 16;
    u32x4 kreg[3], vreg[2];
#pragma unroll
    for (int i = 0; i < 2; ++i) { kreg[i] = *(const u32x4*)(KN + knoff[i]); vreg[i] = *(const u32x4*)(VT + vtoff[i]); }
    kreg[2] = *(const u32x4*)(KR + kroff);
    __syncthreads();
#pragma unroll
    for (int i = 0; i < 2; ++i) { *(LAS u32x4*)(lds + kndst[i]) = kreg[i]; *(LAS u32x4*)(lds + vtdst[i]) = vreg[i]; }
    *(LAS u32x4*)(lds + krdst) = kreg[2];
    __syncthreads();
    for (int kt = 0; kt < nt_unit; ++kt) {
        const bool more = kt + 1 < nt_unit;
        if (more) { const unsigned t1 = (unsigned)(kt + 1) * 64u;
#pragma unroll
            for (int i = 0; i < 2; ++i) { kreg[i] = *(const u32x4*)(KN + (knoff[i] + t1 * 512u)); vreg[i] = *(const u32x4*)(VT + (vtoff[i] + t1)); }
            kreg[2] = *(const u32x4*)(KR + (kroff + t1 * 64u));
        }
        LAS unsigned char* st = lds + (kt & 1) * AT_STAGE;
        if (kt < nt_wave) {
            f32x16 sa[2];
#pragma unroll
            for (int mt = 0; mt < 2; ++mt) {
#pragma unroll
                for (int i = 0; i < 16; ++i) sa[mt][i] = 0.f;
#pragma unroll
                for (int ks = 0; ks < 12; ++ks) { const bf16x8 af = *(const LAS bf16x8*)(st + (32 * mt + r32) * AT_KSTR + 32 * ks + 16 * hi);
                    sa[mt] = __builtin_amdgcn_mfma_f32_32x32x16_bf16(af, qf[ks], sa[mt], 0, 0, 0); }
            }
            float mx = sa[0][0];
#pragma unroll
            for (int i = 1; i < 16; ++i) mx = fmaxf(mx, sa[0][i]);
#pragma unroll
            for (int i = 0; i < 16; ++i) mx = fmaxf(mx, sa[1][i]);
            mx = fmaxf(mx, __shfl_xor(mx, 32));
            const float m_new = fmaxf(m_run, mx); const float alpha = __builtin_amdgcn_exp2f(m_run - m_new); m_run = m_new;
            float ls = 0.f;
#pragma unroll
            for (int mt = 0; mt < 2; ++mt)
#pragma unroll
                for (int i = 0; i < 16; ++i) { const float p = __builtin_amdgcn_exp2f(sa[mt][i] - m_new); sa[mt][i] = p; ls += p; }
            l_run = l_run * alpha + ls;
            if (__builtin_amdgcn_ballot_w64(alpha != 1.0f) != 0ull) {
#pragma unroll
                for (int d = 0; d < 4; ++d)
#pragma unroll
                    for (int i = 0; i < 16; ++i) ot[d][i] *= alpha;
            }
#pragma unroll
            for (int mt = 0; mt < 2; ++mt)
#pragma unroll
                for (int s = 0; s < 2; ++s) { u32x4 w; w.x = pk2(sa[mt][8 * s + 0], sa[mt][8 * s + 1]); w.y = pk2(sa[mt][8 * s + 2], sa[mt][8 * s + 3]); w.z = pk2(sa[mt][8 * s + 4], sa[mt][8 * s + 5]); w.w = pk2(sa[mt][8 * s + 6], sa[mt][8 * s + 7]);
                    const bf16x8 pf = __builtin_bit_cast(bf16x8, w);
#pragma unroll
                    for (int d = 0; d < 4; ++d) { const bf16x8 vf = *(const LAS bf16x8*)(st + AT_KB + (32 * d + r32) * AT_VSTR + 64 * mt + 32 * s + 16 * hi);
                        ot[d] = __builtin_amdgcn_mfma_f32_32x32x16_bf16(vf, pf, ot[d], 0, 0, 0); } }
        }
        if (more) { LAS unsigned char* nx = lds + ((kt + 1) & 1) * AT_STAGE;
#pragma unroll
            for (int i = 0; i < 2; ++i) { *(LAS u32x4*)(nx + kndst[i]) = kreg[i]; *(LAS u32x4*)(nx + vtdst[i]) = vreg[i]; }
            *(LAS u32x4*)(nx + krdst) = kreg[2];
        }
        __syncthreads();
    }
    const float linv = 1.f / (l_run + __shfl_xor(l_run, 32));
    bf16* orow = YC + tokq * DM + h * 128;
#pragma unroll
    for (int d = 0; d < 4; ++d)
#pragma unroll
        for (int g = 0; g < 4; ++g) { u32x2 w; w.x = pk2(ot[d][4 * g] * linv, ot[d][4 * g + 1] * linv); w.y = pk2(ot[d][4 * g + 2] * linv, ot[d][4 * g + 3] * linv); *(u32x2*)(orow + 32 * d + 8 * g + 4 * hi) = w; }
}
constexpr int RW_BLK = 8, RW_VEC = 6 * 64, RW_LDS_WAVE = RW_BLK * RW_VEC * 4;
__device__ __forceinline__ void rw_shift8(const bf16* PR, const float* mix, size_t tok, int s, int col, float* cur) {
    float prv[8]; unpack8(*(const u32x4*)(PR + tok * 1792 + col), cur);
    u32x4 pw = {0u, 0u, 0u, 0u}; if (s > 0) pw = *(const u32x4*)(PR + (tok - 1) * 1792 + col); unpack8(pw, prv);
    const f32x4 m0 = *(const f32x4*)(mix + col), m1 = *(const f32x4*)(mix + col + 4);
#pragma unroll
    for (int e = 0; e < 4; ++e) { cur[e] += (prv[e] - cur[e]) * m0[e]; cur[e + 4] += (prv[e + 4] - cur[e + 4]) * m1[e]; }
}
__device__ __forceinline__ void rw_prep(const Args& a, LAS float* blk, int b, int h, int s0, int lane) {
    unsigned char* ws = a.ws;
    const bf16* PR = (const bf16*)(ws + WS_PRW); const float* DEC = (const float*)(ws + WS_DEC); const bf16* AL = (const bf16*)(ws + WS_AL);
    const float* mix = (const float*)a.in[16]; const float* k_k = (const float*)a.in[22]; const float* k_a = (const float*)a.in[23];
    const int tt = lane >> 3, k0 = 8 * (lane & 7), ch = h * 64 + k0; const int s = s0 + tt; const size_t tok = (size_t)b * SEQ + s;
    LAS float* o = blk + tt * RW_VEC + k0;
    { float r[8]; rw_shift8(PR, mix, tok, s, ch, r); *(LAS f32x4*)(o + 256) = (f32x4){r[0], r[1], r[2], r[3]}; *(LAS f32x4*)(o + 260) = (f32x4){r[4], r[5], r[6], r[7]}; }
    __builtin_amdgcn_sched_barrier(0);
    { float r[8]; rw_shift8(PR, mix, tok, s, 1024 + ch, r); *(LAS f32x4*)(o + 320) = (f32x4){r[0], r[1], r[2], r[3]}; *(LAS f32x4*)(o + 324) = (f32x4){r[4], r[5], r[6], r[7]}; }
    __builtin_amdgcn_sched_barrier(0);
    { const f32x4 d0 = *(const f32x4*)(DEC + tok * 512 + ch), d1 = *(const f32x4*)(DEC + tok * 512 + ch + 4); *(LAS f32x4*)(o) = d0; *(LAS f32x4*)(o + 4) = d1; }
    __builtin_amdgcn_sched_barrier(0);
    float kc[8]; rw_shift8(PR, mix, tok, s, 512 + ch, kc);
    float al[8]; unpack8(*(const u32x4*)(AL + tok * 512 + ch), al);
    const f32x4 kk0 = *(const f32x4*)(k_k + ch), kk1 = *(const f32x4*)(k_k + ch + 4), ka0 = *(const f32x4*)(k_a + ch), ka1 = *(const f32x4*)(k_a + ch + 4);
    float kk[8], ss = 0.f;
#pragma unroll
    for (int e = 0; e < 8; ++e) { kk[e] = kc[e] * (e < 4 ? kk0[e & 3] : kk1[e & 3]); ss += kk[e] * kk[e]; }
    ss += __shfl_xor(ss, 1); ss += __shfl_xor(ss, 2); ss += __shfl_xor(ss, 4);
    const float rn = 1.f / fmaxf(sqrtf(ss), 1e-12f);
    f32x4 t0, t1;
#pragma unroll
    for (int e = 0; e < 4; ++e) { t0[e] = kk[e] * rn; t1[e] = kk[e + 4] * rn; }
    *(LAS f32x4*)(o + 64) = t0; *(LAS f32x4*)(o + 68) = t1;
#pragma unroll
    for (int e = 0; e < 4; ++e) { t0[e] *= al[e]; t1[e] *= al[e + 4]; }
    *(LAS f32x4*)(o + 128) = t0; *(LAS f32x4*)(o + 132) = t1;
#pragma unroll
    for (int e = 0; e < 4; ++e) { t0[e] = kc[e] * (1.f + (al[e] - 1.f) * ka0[e]); t1[e] = kc[e + 4] * (1.f + (al[e + 4] - 1.f) * ka1[e]); }
    *(LAS f32x4*)(o + 192) = t0; *(LAS f32x4*)(o + 196) = t1;
}
#define RW_LDS_FENCE() do { asm volatile("s_waitcnt lgkmcnt(0)" ::: "memory"); __builtin_amdgcn_wave_barrier(); } while (0)
template <bool IDENT>
__device__ __forceinline__ void rw_pass1(const Args& a, LAS float* blk, int item, int lane) {
    const int bh = item / RW_NC, c = item % RW_NC, b = bh >> 3, h = bh & 7;
    float sV[64];
#pragma unroll
    for (int k = 0; k < 64; ++k) sV[k] = (IDENT && k == lane) ? 1.f : 0.f;
    for (int blkI = 0; blkI < RW_T / RW_BLK; ++blkI) {
        RW_LDS_FENCE();
        rw_prep(a, blk, b, h, c * RW_T + blkI * RW_BLK, lane);
        RW_LDS_FENCE();
#pragma unroll 1
        for (int tt = 0; tt < RW_BLK; ++tt) { const LAS float* vb = blk + tt * RW_VEC;
            float dV = 0.f;
#pragma unroll
            for (int k4 = 0; k4 < 16; ++k4) { const f32x4 kk = *(const LAS f32x4*)(vb + 64 + 4 * k4);
#pragma unroll
                for (int e = 0; e < 4; ++e) dV += sV[4 * k4 + e] * kk[e]; }
            const float vv = IDENT ? 0.f : vb[320 + lane];
#pragma unroll
            for (int k4 = 0; k4 < 16; ++k4) { const f32x4 w = *(const LAS f32x4*)(vb + 4 * k4), bb = *(const LAS f32x4*)(vb + 128 + 4 * k4);
                if (IDENT) {
#pragma unroll
                    for (int e = 0; e < 4; ++e) sV[4 * k4 + e] = sV[4 * k4 + e] * w[e] - dV * bb[e];
                } else { const f32x4 kv = *(const LAS f32x4*)(vb + 192 + 4 * k4);
#pragma unroll
                    for (int e = 0; e < 4; ++e) sV[4 * k4 + e] = sV[4 * k4 + e] * w[e] + (vv * kv[e] - dV * bb[e]); } }
        }
    }
    float* O = (float*)(a.ws + (IDENT ? WS_G : WS_J)) + ((size_t)item * 64 + lane) * 64;
#pragma unroll
    for (int k4 = 0; k4 < 16; ++k4) *(f32x4*)(O + 4 * k4) = (f32x4){sV[4 * k4], sV[4 * k4 + 1], sV[4 * k4 + 2], sV[4 * k4 + 3]};
}
__device__ __forceinline__ void rw_pass3(const Args& a, LAS float* blk, int item, int lane) {
    const int bh = item / RW_NC, c = item % RW_NC, b = bh >> 3, h = bh & 7, ch = h * 64 + lane;
    float sV[64];
    { const float* S0 = (const float*)(a.ws + WS_SST) + ((size_t)item * 64 + lane) * 64;
#pragma unroll
      for (int k4 = 0; k4 < 16; ++k4) { const f32x4 t = *(const f32x4*)(S0 + 4 * k4); sV[4 * k4] = t.x; sV[4 * k4 + 1] = t.y; sV[4 * k4 + 2] = t.z; sV[4 * k4 + 3] = t.w; } }
    const float rk = ((const float*)a.in[24])[ch], lnw = ((const float*)a.in[25])[ch], lnb = ((const float*)a.in[26])[ch];
    bf16* YC = (bf16*)(a.ws + WS_U);
    for (int blkI = 0; blkI < RW_T / RW_BLK; ++blkI) {
        RW_LDS_FENCE();
        rw_prep(a, blk, b, h, c * RW_T + blkI * RW_BLK, lane);
        RW_LDS_FENCE();
#pragma unroll 1
        for (int tt = 0; tt < RW_BLK; ++tt) { const LAS float* vb = blk + tt * RW_VEC;
            float dV = 0.f;
#pragma unroll
            for (int k4 = 0; k4 < 16; ++k4) { const f32x4 kk = *(const LAS f32x4*)(vb + 64 + 4 * k4);
#pragma unroll
                for (int e = 0; e < 4; ++e) dV += sV[4 * k4 + e] * kk[e]; }
            const float vv = vb[320 + lane]; float y = 0.f;
#pragma unroll
            for (int k4 = 0; k4 < 16; ++k4) { const f32x4 w = *(const LAS f32x4*)(vb + 4 * k4), bb = *(const LAS f32x4*)(vb + 128 + 4 * k4), kv = *(const LAS f32x4*)(vb + 192 + 4 * k4), r = *(const LAS f32x4*)(vb + 256 + 4 * k4);
#pragma unroll
                for (int e = 0; e < 4; ++e) { const float sn = sV[4 * k4 + e] * w[e] + (vv * kv[e] - dV * bb[e]); sV[4 * k4 + e] = sn; y += sn * r[e]; } }
            float s1 = y, s2 = y * y, s3 = vb[256 + lane] * vb[192 + lane] * rk;
#pragma unroll
            for (int o = 1; o < 64; o <<= 1) { s1 += __shfl_xor(s1, o); s2 += __shfl_xor(s2, o); s3 += __shfl_xor(s3, o); }
            const float mean = s1 * (1.f / 64.f), var = fmaxf(s2 * (1.f / 64.f) - mean * mean, 0.f);
            const float yn = (y - mean) * rsqrtf(var + 64e-5f) * lnw + lnb;
            bf16* gp = YC + ((size_t)b * SEQ + c * RW_T + blkI * RW_BLK + tt) * DM + 512 + ch;
            const float g = bf2f(*gp);
            *gp = (bf16)(pk2((yn + s3 * vv) * g, 0.f) & 0xffffu);
        }
    }
}
__device__ __forceinline__ void rw_scan(const Args& a, LAS unsigned char* lds, int bh, int tid) {
    LAS float* Sb = (LAS float*)lds; LAS float* Gb = (LAS float*)(lds + 64 * 68 * 4);
    const int v = tid >> 3, k0 = 8 * (tid & 7);
    const float* G = (const float*)(a.ws + WS_G) + (size_t)bh * RW_NC * 4096; const float* J = (const float*)(a.ws + WS_J) + (size_t)bh * RW_NC * 4096; float* SST = (float*)(a.ws + WS_SST) + (size_t)bh * RW_NC * 4096;
    f32x4 s0 = {0.f, 0.f, 0.f, 0.f}, s1 = s0;
    f32x4 g0 = *(const f32x4*)(G + tid * 8), g1 = *(const f32x4*)(G + tid * 8 + 4), j0 = *(const f32x4*)(J + v * 64 + k0), j1 = *(const f32x4*)(J + v * 64 + k0 + 4);
    for (int c = 0; c < RW_NC; ++c) {
        *(f32x4*)(SST + (size_t)c * 4096 + v * 64 + k0) = s0; *(f32x4*)(SST + (size_t)c * 4096 + v * 64 + k0 + 4) = s1;
        if (c == RW_NC - 1) break;
        *(LAS f32x4*)(Sb + v * 68 + k0) = s0; *(LAS f32x4*)(Sb + v * 68 + k0 + 4) = s1;
        *(LAS f32x4*)(Gb + tid * 8) = g0; *(LAS f32x4*)(Gb + tid * 8 + 4) = g1;
        f32x4 a0 = j0, a1 = j1;
        __syncthreads();
        if (c + 1 < RW_NC - 1) { const size_t o = (size_t)(c + 1) * 4096; g0 = *(const f32x4*)(G + o + tid * 8); g1 = *(const f32x4*)(G + o + tid * 8 + 4); j0 = *(const f32x4*)(J + o + v * 64 + k0); j1 = *(const f32x4*)(J + o + v * 64 + k0 + 4); }
#pragma unroll 4
        for (int i4 = 0; i4 < 16; ++i4) { const f32x4 sv = *(const LAS f32x4*)(Sb + v * 68 + 4 * i4);
#pragma unroll
            for (int e = 0; e < 4; ++e) { const f32x4 ga = *(const LAS f32x4*)(Gb + (4 * i4 + e) * 64 + k0), gb = *(const LAS f32x4*)(Gb + (4 * i4 + e) * 64 + k0 + 4); a0 += ga * sv[e]; a1 += gb * sv[e]; } }
        s0 = a0; s1 = a1;
        __syncthreads();
    }
}

constexpr int SQ_BLK = 16, SQ_VEC = 392, SQ_BUF = SQ_BLK * SQ_VEC * 4, SQ_YOFF = 2 * SQ_BUF, SQ_YBUF = SQ_BLK * 64 * 8, SQ_NBLK = SEQ / SQ_BLK;
__device__ __forceinline__ float dpp_f(float v, const int ctrl) { return v; }
#define DPPF(v, ctrl) __builtin_bit_cast(float, __builtin_amdgcn_update_dpp(0, __builtin_bit_cast(int, (v)), (ctrl), 0xF, 0xF, true))
__device__ __forceinline__ float red8(float v) { v += DPPF(v, 0xB1); v += DPPF(v, 0x4E); v += DPPF(v, 0x141); return v; }
__device__ __forceinline__ void rw_seq(const Args& a, LAS unsigned char* lds, int bh, int tid, bool do_store) {
    const int b = bh >> 3, h = bh & 7, wave = __builtin_amdgcn_readfirstlane(tid >> 6), lane = tid & 63;
    unsigned char* ws = a.ws;
    if (wave >= 4) {
        const int tp = tid - 256, tt = tp >> 4, kq = tp & 15, k0 = 4 * kq, ch = h * 64 + k0;
        const bf16* PR = (const bf16*)(ws + WS_PRW); const float* DEC = (const float*)(ws + WS_DEC); const bf16* AL = (const bf16*)(ws + WS_AL); bf16* YC = (bf16*)(ws + WS_U);
        const float* mixp = (const float*)a.in[16];
        const f32x4 mx0 = *(const f32x4*)(mixp + ch), mx1 = *(const f32x4*)(mixp + 512 + ch), mx2 = *(const f32x4*)(mixp + 1024 + ch);
        const f32x4 kkc = *(const f32x4*)((const float*)a.in[22] + ch), kac = *(const f32x4*)((const float*)a.in[23] + ch), rkc = *(const f32x4*)((const float*)a.in[24] + ch);
        const f32x4 lnw = *(const f32x4*)((const float*)a.in[25] + ch), lnb = *(const f32x4*)((const float*)a.in[26] + ch);
        u32x2 cur[3], prv[3], alr; f32x4 dcr; u32x2 cur2[3], prv2[3], alr2; f32x4 dcr2; u32x2 gq = {0u, 0u};
        { const size_t tok = (size_t)b * SEQ + tt;
#pragma unroll
          for (int j = 0; j < 3; ++j) { cur[j] = *(const u32x2*)(PR + tok * 1792 + 512 * j + ch); prv[j] = (u32x2){0u, 0u}; if (tt > 0) prv[j] = *(const u32x2*)(PR + (tok - 1) * 1792 + 512 * j + ch); }
          alr = *(const u32x2*)(AL + tok * 512 + ch); dcr = *(const f32x4*)(DEC + tok * 512 + ch); }
        { const size_t tok = (size_t)b * SEQ + SQ_BLK + tt;
#pragma unroll
          for (int j = 0; j < 3; ++j) { cur2[j] = *(const u32x2*)(PR + tok * 1792 + 512 * j + ch); prv2[j] = *(const u32x2*)(PR + (tok - 1) * 1792 + 512 * j + ch); }
          alr2 = *(const u32x2*)(AL + tok * 512 + ch); dcr2 = *(const f32x4*)(DEC + tok * 512 + ch); }
        for (int n = 0; n <= SQ_NBLK + 1; ++n) {
            if (n < SQ_NBLK) {
                LAS float* o = (LAS float*)(lds + (n & 1) * SQ_BUF) + tt * SQ_VEC + k0;
                f32x4 r4, k4, v4, al4;
                { const f32x4 c0 = {bf2f(cur[0].x & 0xffffu), bf2f(cur[0].x >> 16), bf2f(cur[0].y & 0xffffu), bf2f(cur[0].y >> 16)}, p0 = {bf2f(prv[0].x & 0xffffu), bf2f(prv[0].x >> 16), bf2f(prv[0].y & 0xffffu), bf2f(prv[0].y >> 16)}; r4 = c0 + (p0 - c0) * mx0; }
                { const f32x4 c0 = {bf2f(cur[1].x & 0xffffu), bf2f(cur[1].x >> 16), bf2f(cur[1].y & 0xffffu), bf2f(cur[1].y >> 16)}, p0 = {bf2f(prv[1].x & 0xffffu), bf2f(prv[1].x >> 16), bf2f(prv[1].y & 0xffffu), bf2f(prv[1].y >> 16)}; k4 = c0 + (p0 - c0) * mx1; }
                { const f32x4 c0 = {bf2f(cur[2].x & 0xffffu), bf2f(cur[2].x >> 16), bf2f(cur[2].y & 0xffffu), bf2f(cur[2].y >> 16)}, p0 = {bf2f(prv[2].x & 0xffffu), bf2f(prv[2].x >> 16), bf2f(prv[2].y & 0xffffu), bf2f(prv[2].y >> 16)}; v4 = c0 + (p0 - c0) * mx2; }
                al4 = (f32x4){bf2f(alr.x & 0xffffu), bf2f(alr.x >> 16), bf2f(alr.y & 0xffffu), bf2f(alr.y >> 16)};
                f32x4 kk = k4 * kkc; float ss = (kk.x * kk.x + kk.y * kk.y) + (kk.z * kk.z + kk.w * kk.w);
                ss += __shfl_xor(ss, 1); ss += __shfl_xor(ss, 2); ss += __shfl_xor(ss, 4); ss += __shfl_xor(ss, 8);
                const float rn = 1.f / fmaxf(sqrtf(ss), 1e-12f); kk = kk * rn;
                const f32x4 kv = k4 * ((al4 - 1.f) * kac + 1.f);
                const f32x4 cp = r4 * kv * rkc; float cs = (cp.x + cp.y) + (cp.z + cp.w);
                cs += __shfl_xor(cs, 1); cs += __shfl_xor(cs, 2); cs += __shfl_xor(cs, 4); cs += __shfl_xor(cs, 8);
                *(LAS f32x4*)(o) = dcr; *(LAS f32x4*)(o + 64) = kk; *(LAS f32x4*)(o + 128) = kk * al4; *(LAS f32x4*)(o + 192) = kv; *(LAS f32x4*)(o + 256) = r4; *(LAS f32x4*)(o + 320) = v4;
                if (kq == 0) o[384] = cs;
            }
#pragma unroll
            for (int j = 0; j < 3; ++j) { cur[j] = cur2[j]; prv[j] = prv2[j]; }
            alr = alr2; dcr = dcr2;
            if (n + 2 < SQ_NBLK) { const size_t tok = (size_t)b * SEQ + (n + 2) * SQ_BLK + tt;
#pragma unroll
                for (int j = 0; j < 3; ++j) { cur2[j] = *(const u32x2*)(PR + tok * 1792 + 512 * j + ch); prv2[j] = *(const u32x2*)(PR + (tok - 1) * 1792 + 512 * j + ch); }
                alr2 = *(const u32x2*)(AL + tok * 512 + ch); dcr2 = *(const f32x4*)(DEC + tok * 512 + ch); }
            if (n >= 2) {
                const LAS f32x4* yb = (const LAS f32x4*)(lds + SQ_YOFF + (n & 1) * SQ_YBUF) + (tt * 64 + k0) / 2;
                const f32x4 y01 = yb[0], y23 = yb[1];
                float s1 = (y01.x + y01.z) + (y23.x + y23.z), s2 = (y01.x * y01.x + y01.z * y01.z) + (y23.x * y23.x + y23.z * y23.z);
#pragma unroll
                for (int o = 1; o < 16; o <<= 1) { s1 += __shfl_xor(s1, o); s2 += __shfl_xor(s2, o); }
                const float mean = s1 * (1.f / 64.f), var = fmaxf(s2 * (1.f / 64.f) - mean * mean, 0.f), rstd = rsqrtf(var + 64e-5f);
                bf16* gp = YC + ((size_t)b * SEQ + (n - 2) * SQ_BLK + tt) * DM + 512 + ch;
                const u32x2 gw = gq;
                const float o0 = (((y01.x - mean) * rstd) * lnw.x + lnb.x + y01.y) * bf2f(gw.x & 0xffffu), o1 = (((y01.z - mean) * rstd) * lnw.y + lnb.y + y01.w) * bf2f(gw.x >> 16);
                const float o2 = (((y23.x - mean) * rstd) * lnw.z + lnb.z + y23.y) * bf2f(gw.y & 0xffffu), o3 = (((y23.z - mean) * rstd) * lnw.w + lnb.w + y23.w) * bf2f(gw.y >> 16);
                u32x2 w; w.x = pk2(o0, o1); w.y = pk2(o2, o3); if (do_store) *(u32x2*)gp = w;
            }
            if (n >= 1 && n <= SQ_NBLK) gq = *(const u32x2*)(YC + ((size_t)b * SEQ + (n - 1) * SQ_BLK + tt) * DM + 512 + ch);
            __syncthreads();
        }
    } else {
        const int rg = lane >> 3, kq = lane & 7, r0 = 16 * wave + 2 * rg;
        f32x2 s0[4], s1[4];
#pragma unroll
        for (int i = 0; i < 4; ++i) { s0[i] = (f32x2){0.f, 0.f}; s1[i] = (f32x2){0.f, 0.f}; }
        for (int n = 0; n <= SQ_NBLK + 1; ++n) {
            if (n >= 1 && n <= SQ_NBLK) {
                const LAS float* vbase = (const LAS float*)(lds + ((n - 1) & 1) * SQ_BUF) + 8 * kq;
                LAS f32x4* yb = (LAS f32x4*)(lds + SQ_YOFF + ((n - 1) & 1) * SQ_YBUF) + r0 / 2;
#define SQ_LOAD(P, tt_) do { const LAS float* vb_ = vbase + (tt_) * SQ_VEC; P##ka = *(const LAS f32x4*)(vb_ + 64); P##kb = *(const LAS f32x4*)(vb_ + 68); P##wa = *(const LAS f32x4*)(vb_); P##wb = *(const LAS f32x4*)(vb_ + 4); \
        P##ba = *(const LAS f32x4*)(vb_ + 128); P##bb = *(const LAS f32x4*)(vb_ + 132); P##va = *(const LAS f32x4*)(vb_ + 192); P##vbv = *(const LAS f32x4*)(vb_ + 196); P##ra = *(const LAS f32x4*)(vb_ + 256); P##rb = *(const LAS f32x4*)(vb_ + 260); \
        P##vv = *(const LAS f32x2*)(vb_ - 8 * kq + 320 + r0); P##ct = vb_[384 - 8 * kq]; } while (0)
#define SQ_STEP(P, tt_) do { \
        const f32x2 kk[4] = {{P##ka.x, P##ka.y}, {P##ka.z, P##ka.w}, {P##kb.x, P##kb.y}, {P##kb.z, P##kb.w}}, ww[4] = {{P##wa.x, P##wa.y}, {P##wa.z, P##wa.w}, {P##wb.x, P##wb.y}, {P##wb.z, P##wb.w}}; \
        const f32x2 bq[4] = {{P##ba.x, P##ba.y}, {P##ba.z, P##ba.w}, {P##bb.x, P##bb.y}, {P##bb.z, P##bb.w}}, kv[4] = {{P##va.x, P##va.y}, {P##va.z, P##va.w}, {P##vbv.x, P##vbv.y}, {P##vbv.z, P##vbv.w}}; \
        const f32x2 rr[4] = {{P##ra.x, P##ra.y}, {P##ra.z, P##ra.w}, {P##rb.x, P##rb.y}, {P##rb.z, P##rb.w}}; \
        const f32x2 d0 = (s0[0] * kk[0] + s0[1] * kk[1]) + (s0[2] * kk[2] + s0[3] * kk[3]), d1 = (s1[0] * kk[0] + s1[1] * kk[1]) + (s1[2] * kk[2] + s1[3] * kk[3]); \
        f32x2 t0[4], t1[4]; \
        _Pragma("unroll") for (int i = 0; i < 4; ++i) { t0[i] = kv[i] * P##vv.x; t1[i] = kv[i] * P##vv.y; s0[i] = s0[i] * ww[i]; s1[i] = s1[i] * ww[i]; } \
        const float sa0 = -red8(d0.x + d0.y), sa1 = -red8(d1.x + d1.y); \
        f32x2 y0 = {0.f, 0.f}, y1 = {0.f, 0.f}; \
        _Pragma("unroll") for (int i = 0; i < 4; ++i) { s0[i] += t0[i] + bq[i] * sa0; s1[i] += t1[i] + bq[i] * sa1; y0 += s0[i] * rr[i]; y1 += s1[i] * rr[i]; } \
        const float ya = red8(y0.x + y0.y), yb1 = red8(y1.x + y1.y); \
        if (kq == 0) yb[(tt_) * 32] = (f32x4){ya, P##ct * P##vv.x, yb1, P##ct * P##vv.y}; } while (0)
                f32x4 Aka, Akb, Awa, Awb, Aba, Abb, Ava, Avbv, Ara, Arb, Bka, Bkb, Bwa, Bwb, Bba, Bbb, Bva, Bvbv, Bra, Brb; f32x2 Avv, Bvv; float Act, Bct;
                SQ_LOAD(A, 0);
#pragma unroll 1
                for (int tt = 0; tt < SQ_BLK; tt += 2) {
                    SQ_LOAD(B, tt + 1);
                    SQ_STEP(A, tt);
                    if (tt + 2 < SQ_BLK) SQ_LOAD(A, tt + 2);
                    SQ_STEP(B, tt + 1);
                }
            }
            __syncthreads();
        }
    }
}
constexpr int WY_T = 16, WY_NCH = SEQ / WY_T, WY_NP = 6;
constexpr int WY_AZ = 0, WY_AY1 = 2048, WY_AU = 4096, WY_AY2 = 5120, WY_AS = 6144, WY_VT = 10240, WY_PT = 12288, WY_SCR = 12544, WY_SLOT = 12544 + 5120, WY_FLAGS = WY_NP * WY_SLOT;
__device__ __forceinline__ int wy_perm_off(int t, int k) { const int n = k >> 4; return (n >> 1) * 1024 + t * 64 + ((k >> 2) & 3) * 16 + ((n & 1) * 4 + (k & 3)) * 2; }
__device__ __forceinline__ float red64(float v) { v += DPPF(v, 0xB1); v += DPPF(v, 0x4E); v += DPPF(v, 0x141); v += DPPF(v, 0x140); v += __shfl_xor(v, 16); v += __shfl_xor(v, 32); return v; }
__device__ __forceinline__ unsigned short bf1(float x) { return (unsigned short)(pk2(x, 0.f) & 0xffffu); }
#define WY_FENCE() do { asm volatile("s_waitcnt lgkmcnt(0)" ::: "memory"); __builtin_amdgcn_wave_barrier(); } while (0)
constexpr int WY_STGSZ = 6528, WY_STG = WY_NP * WY_SLOT + 64;
__device__ __forceinline__ void wy_issue(const Args& a, LAS unsigned char* stg, int b, int h, int c, int lane, float (&dec)[WY_T], float (&al)[WY_T], float (&rn)[WY_T]) {
    unsigned char* ws = a.ws;
    const bf16* PR = (const bf16*)(ws + WS_PRW); const float* DEC = (const float*)(ws + WS_DEC); const bf16* AL = (const bf16*)(ws + WS_AL); const float* CT = (const float*)(ws + WS_CT);
    const size_t tok0 = (size_t)b * SEQ + (size_t)c * WY_T; const int ch = h * 64 + lane;
#pragma unroll
    for (int j = 0; j < 7; ++j) { const int idx = j * 64 + lane;
        if (idx < 408) { const int row = idx >> 3, trel = row / 3, vec = row - 3 * trel; size_t tk = tok0 + trel; tk = (tk == 0) ? 1 : tk;
            __builtin_amdgcn_global_load_lds((const unsigned*)(PR + (tk - 1) * 1792 + vec * 512 + h * 64 + (idx & 7) * 8), (LAS unsigned*)(stg + j * 1024), 16, 0, 0); } }
#pragma unroll
    for (int t = 0; t < WY_T; ++t) { dec[t] = DEC[(tok0 + t) * 512 + ch]; al[t] = bf2f(AL[(tok0 + t) * 512 + ch]); rn[t] = CT[(tok0 + t) * 8 + h]; }
}
__device__ __forceinline__ void wy_build1(const Args& a, LAS unsigned char* slot, const LAS unsigned char* stg, int h, int c, int lane, const float (&dec)[WY_T], const float (&alr)[WY_T], const float (&rn)[WY_T]) {
    const int ch = h * 64 + lane;
    const float mixr = ((const float*)a.in[16])[ch], mixk = ((const float*)a.in[16])[512 + ch], mixv = ((const float*)a.in[16])[1024 + ch];
    const float k_k = ((const float*)a.in[22])[ch], k_a = ((const float*)a.in[23])[ch];
    float bv[WY_T], kv[WY_T], Pt[WY_T], vx[WY_T];
    const LAS unsigned short* sg = (const LAS unsigned short*)stg + lane;
    float pr = bf2f(sg[0]), pk = bf2f(sg[64]), pvv = bf2f(sg[128]);
    if (c == 0) { pr = 0.f; pk = 0.f; pvv = 0.f; }
    float Pcum = 1.f;
    LAS unsigned char* scr = slot + WY_SCR;
#pragma unroll
    for (int t = 0; t < WY_T; ++t) {
        const float cr = bf2f(sg[(3 * (t + 1)) * 64]), ck = bf2f(sg[(3 * (t + 1) + 1) * 64]), cv = bf2f(sg[(3 * (t + 1) + 2) * 64]);
        const float w = dec[t], al = alr[t];
        const float r = cr + (pr - cr) * mixr, kx = ck + (pk - ck) * mixk; vx[t] = cv + (pvv - cv) * mixv; pr = cr; pk = ck; pvv = cv;
        const float kkn = kx * k_k * rn[t];
        bv[t] = kkn * al; kv[t] = kx * (1.f + (al - 1.f) * k_a);
        const float Pprev = Pcum; Pcum *= w; const float invP = __builtin_amdgcn_rcpf(Pcum); Pt[t] = invP;
        const int po = wy_perm_off(t, lane);
        *(LAS unsigned short*)(slot + WY_AZ + po) = bf1(-kkn * Pprev); *(LAS unsigned short*)(slot + WY_AY1 + po) = bf1(r * Pcum);
        *(LAS unsigned short*)(scr + po) = bf1(bv[t] * invP); *(LAS unsigned short*)(scr + 2048 + po) = bf1(kv[t] * invP);
    }
    { u32x4 w0, w1; w0.x = pk2(vx[0], vx[1]); w0.y = pk2(vx[2], vx[3]); w0.z = pk2(vx[4], vx[5]); w0.w = pk2(vx[6], vx[7]); w1.x = pk2(vx[8], vx[9]); w1.y = pk2(vx[10], vx[11]); w1.z = pk2(vx[12], vx[13]); w1.w = pk2(vx[14], vx[15]);
      *(LAS u32x4*)(slot + WY_VT + lane * 32) = w0; *(LAS u32x4*)(slot + WY_VT + lane * 32 + 16) = w1; }
    *(LAS float*)(slot + WY_PT + lane * 4) = Pcum;
#pragma unroll
    for (int g = 0; g < 4; ++g) { float bh4[4], kh4[4];
#pragma unroll
        for (int j = 0; j < 4; ++j) { const float sc = Pcum * Pt[4 * g + j]; bh4[j] = bv[4 * g + j] * sc; kh4[j] = kv[4 * g + j] * sc; }
        u32x4 w; w.x = pk2(bh4[0], bh4[1]); w.y = pk2(bh4[2], bh4[3]); w.z = pk2(kh4[0], kh4[1]); w.w = pk2(kh4[2], kh4[3]);
        *(LAS u32x4*)(slot + WY_AS + (lane >> 4) * 1024 + (lane & 15) * 64 + g * 16) = w; }
}
__device__ __forceinline__ void wy_build2(LAS unsigned char* slot, int lane) {
    LAS unsigned char* scr = slot + WY_SCR;
    const int row = lane & 15, g = lane >> 4; const int fo = row * 64 + g * 16;
    f32x4 m1 = {0.f, 0.f, 0.f, 0.f}, m2 = m1, m3 = m1, m4 = m1;
#pragma unroll
    for (int s = 0; s < 2; ++s) { const bf16x8 fa = *(const LAS bf16x8*)(slot + WY_AZ + s * 1024 + fo), fr = *(const LAS bf16x8*)(slot + WY_AY1 + s * 1024 + fo), fb = *(const LAS bf16x8*)(scr + s * 1024 + fo), fk = *(const LAS bf16x8*)(scr + 2048 + s * 1024 + fo);
        m1 = __builtin_amdgcn_mfma_f32_16x16x32_bf16(fa, fb, m1, 0, 0, 0); m2 = __builtin_amdgcn_mfma_f32_16x16x32_bf16(fa, fk, m2, 0, 0, 0);
        m3 = __builtin_amdgcn_mfma_f32_16x16x32_bf16(fr, fb, m3, 0, 0, 0); m4 = __builtin_amdgcn_mfma_f32_16x16x32_bf16(fr, fk, m4, 0, 0, 0); }
    WY_FENCE();
#pragma unroll
    for (int i = 0; i < 4; ++i) { const int t = 4 * g + i; const bool lo = row < t, le = row <= t;
        *(LAS float*)(scr + (t * 16 + row) * 4) = lo ? m1[i] : 0.f; *(LAS float*)(scr + 1024 + (t * 16 + row) * 4) = lo ? m2[i] : 0.f;
        *(LAS float*)(scr + 2048 + (t * 16 + row) * 4) = le ? m3[i] : 0.f; *(LAS float*)(scr + 3072 + (t * 16 + row) * 4) = le ? m4[i] : 0.f; }
    WY_FENCE();
    { float x[WY_T];
#pragma unroll
      for (int t = 0; t < WY_T; ++t) x[t] = (t == row) ? 1.f : 0.f;
#pragma unroll
      for (int t = 1; t < WY_T; ++t) { float acc = x[t];
#pragma unroll
          for (int s4 = 0; s4 < (t + 3) / 4; ++s4) { const f32x4 mr = *(const LAS f32x4*)(scr + (t * 16 + 4 * s4) * 4);
#pragma unroll
              for (int e = 0; e < 4; ++e) if (4 * s4 + e < t) acc += mr[e] * x[4 * s4 + e]; }
          x[t] = acc; }
      if (lane < 16) {
#pragma unroll
          for (int t = 0; t < WY_T; ++t) *(LAS float*)(scr + 4096 + (t * 16 + row) * 4) = x[t]; } }
    WY_FENCE();
    { const int t = lane >> 2, gq = lane & 3; f32x4 tm = {0.f, 0.f, 0.f, 0.f};
#pragma unroll
      for (int s4 = 0; s4 < 4; ++s4) { const f32x4 ti = *(const LAS f32x4*)(scr + 4096 + (t * 16 + 4 * s4) * 4);
#pragma unroll
          for (int e = 0; e < 4; ++e) { const f32x4 mr = *(const LAS f32x4*)(scr + 1024 + ((4 * s4 + e) * 16 + 4 * gq) * 4); tm += mr * ti[e]; } }
      const f32x4 ti4 = *(const LAS f32x4*)(scr + 4096 + (t * 16 + 4 * gq) * 4), m34 = *(const LAS f32x4*)(scr + 2048 + (t * 16 + 4 * gq) * 4), m44 = *(const LAS f32x4*)(scr + 3072 + (t * 16 + 4 * gq) * 4);
      u32x4 w; w.x = pk2(ti4.x, ti4.y); w.y = pk2(ti4.z, ti4.w); w.z = pk2(tm.x, tm.y); w.w = pk2(tm.z, tm.w); *(LAS u32x4*)(slot + WY_AU + t * 64 + gq * 16) = w;
      w.x = pk2(m34.x, m34.y); w.y = pk2(m34.z, m34.w); w.z = pk2(m44.x, m44.y); w.w = pk2(m44.z, m44.w); *(LAS u32x4*)(slot + WY_AY2 + t * 64 + gq * 16) = w; }
    WY_FENCE();
}
__device__ __forceinline__ void rw_wy(const Args& a, LAS unsigned char* lds, int bh, int tid) {
    const int b = bh >> 3, h = bh & 7, wave = __builtin_amdgcn_readfirstlane(tid >> 6), lane = tid & 63;
    LAS int* flags = (LAS int*)(lds + WY_FLAGS);
    static_assert(WY_STG + WY_NP * WY_STGSZ <= LDS_BYTES - 32, "WY LDS map");
    if (tid < 16) flags[tid] = (tid == 8 || tid == 9) ? 1 : 0;
    f32x4 ST[2][4];
    { LAS float* blk = (LAS float*)lds;
      if (wave == 2) rw_prep(a, blk, b, h, 0, lane); else if (wave == 3) rw_prep(a, blk + 8 * RW_VEC, b, h, 8, lane);
      asm volatile("s_waitcnt lgkmcnt(0)" ::: "memory");
      __syncthreads();
      if (wave < 2) { const int vl = lane & 15, g = lane >> 4; float* YB0 = (float*)(a.ws + WS_YB);
#pragma unroll
          for (int vt = 0; vt < 2; ++vt)
#pragma unroll
              for (int n = 0; n < 4; ++n) ST[vt][n] = (f32x4){0.f, 0.f, 0.f, 0.f};
#pragma unroll 1
          for (int tt = 0; tt < WY_T; ++tt) { const LAS float* vb = blk + tt * RW_VEC + 4 * g; f32x4 kk4[4], w4[4], bb4[4], kv4[4], r4[4];
#pragma unroll
              for (int n = 0; n < 4; ++n) { w4[n] = *(const LAS f32x4*)(vb + 16 * n); kk4[n] = *(const LAS f32x4*)(vb + 64 + 16 * n); bb4[n] = *(const LAS f32x4*)(vb + 128 + 16 * n); kv4[n] = *(const LAS f32x4*)(vb + 192 + 16 * n); r4[n] = *(const LAS f32x4*)(vb + 256 + 16 * n); }
#pragma unroll
              for (int vt = 0; vt < 2; ++vt) { const int v = 32 * wave + 16 * vt + vl; const float vv = blk[tt * RW_VEC + 320 + v];
                  f32x4 dv = ST[vt][0] * kk4[0] + ST[vt][1] * kk4[1] + ST[vt][2] * kk4[2] + ST[vt][3] * kk4[3]; float dd = (dv.x + dv.y) + (dv.z + dv.w);
                  dd += __shfl_xor(dd, 16); dd += __shfl_xor(dd, 32); const float sa = -dd;
                  f32x4 yv = {0.f, 0.f, 0.f, 0.f};
#pragma unroll
                  for (int n = 0; n < 4; ++n) { ST[vt][n] = ST[vt][n] * w4[n] + (kv4[n] * vv + bb4[n] * sa); yv += ST[vt][n] * r4[n]; }
                  float y = (yv.x + yv.y) + (yv.z + yv.w); y += __shfl_xor(y, 16); y += __shfl_xor(y, 32);
                  if (g == 0) YB0[((size_t)b * SEQ + tt) * 512 + h * 64 + v] = y; } } }
      __syncthreads(); }
    if (wave >= 2) {
        const int p = wave - 2; LAS unsigned char* slot = lds + p * WY_SLOT; LAS unsigned char* stg = lds + WY_STG + p * WY_STGSZ;
        float dec[WY_T], alr[WY_T], rn[WY_T];
        const int c_first = (p == 0) ? WY_NP : p;
        wy_issue(a, stg, b, h, c_first, lane, dec, alr, rn);
        for (int c = c_first; c < WY_NCH; c += WY_NP) {
            while (min(__hip_atomic_load(flags + 8, __ATOMIC_ACQUIRE, __HIP_MEMORY_SCOPE_WORKGROUP), __hip_atomic_load(flags + 9, __ATOMIC_ACQUIRE, __HIP_MEMORY_SCOPE_WORKGROUP)) < c - (WY_NP - 1)) __builtin_amdgcn_s_sleep(2);
            asm volatile("s_waitcnt vmcnt(0)" ::: "memory"); __builtin_amdgcn_wave_barrier();
            wy_build1(a, slot, stg, h, c, lane, dec, alr, rn);
            WY_FENCE();
            if (c + WY_NP < WY_NCH) wy_issue(a, stg, b, h, c + WY_NP, lane, dec, alr, rn);
            wy_build2(slot, lane);
            if (lane == 0) __hip_atomic_store(flags + p, c + 1, __ATOMIC_RELEASE, __HIP_MEMORY_SCOPE_WORKGROUP);
        }
    } else {
        float* YB = (float*)(a.ws + WS_YB);
        const int vl = lane & 15, g = lane >> 4;
        const f32x4 zero4 = {0.f, 0.f, 0.f, 0.f};
        for (int c = 1; c < WY_NCH; ++c) { const int p = c % WY_NP; const LAS unsigned char* slot = lds + p * WY_SLOT;
            while (__hip_atomic_load(flags + p, __ATOMIC_ACQUIRE, __HIP_MEMORY_SCOPE_WORKGROUP) != c + 1) __builtin_amdgcn_s_sleep(1);
            const int fo = vl * 64 + g * 16;
            f32x4 PT4[4];
#pragma unroll
            for (int n = 0; n < 4; ++n) PT4[n] = *(const LAS f32x4*)(slot + WY_PT + (16 * n + 4 * g) * 4);
            const bf16x8 az0 = *(const LAS bf16x8*)(slot + WY_AZ + fo), az1 = *(const LAS bf16x8*)(slot + WY_AZ + 1024 + fo), ay0 = *(const LAS bf16x8*)(slot + WY_AY1 + fo), ay1 = *(const LAS bf16x8*)(slot + WY_AY1 + 1024 + fo);
            const bf16x8 au = *(const LAS bf16x8*)(slot + WY_AU + fo), ay2 = *(const LAS bf16x8*)(slot + WY_AY2 + fo);
            const size_t tokg = (size_t)b * SEQ + (size_t)c * WY_T + 4 * g;
#pragma unroll
            for (int vt = 0; vt < 2; ++vt) { const int v = 32 * wave + 16 * vt + vl;
                u32x4 s0w, s1w; s0w.x = pk2(ST[vt][0].x, ST[vt][0].y); s0w.y = pk2(ST[vt][0].z, ST[vt][0].w); s0w.z = pk2(ST[vt][1].x, ST[vt][1].y); s0w.w = pk2(ST[vt][1].z, ST[vt][1].w);
                s1w.x = pk2(ST[vt][2].x, ST[vt][2].y); s1w.y = pk2(ST[vt][2].z, ST[vt][2].w); s1w.z = pk2(ST[vt][3].x, ST[vt][3].y); s1w.w = pk2(ST[vt][3].z, ST[vt][3].w);
                const bf16x8 sf0 = __builtin_bit_cast(bf16x8, s0w), sf1 = __builtin_bit_cast(bf16x8, s1w);
                f32x4 z = __builtin_amdgcn_mfma_f32_16x16x32_bf16(az0, sf0, zero4, 0, 0, 0); z = __builtin_amdgcn_mfma_f32_16x16x32_bf16(az1, sf1, z, 0, 0, 0);
                const u32x2 vq = *(const LAS u32x2*)(slot + WY_VT + v * 32 + g * 8);
                u32x4 f1w; f1w.x = pk2(z.x, z.y); f1w.y = pk2(z.z, z.w); f1w.z = vq.x; f1w.w = vq.y;
                const f32x4 u = __builtin_amdgcn_mfma_f32_16x16x32_bf16(au, __builtin_bit_cast(bf16x8, f1w), zero4, 0, 0, 0);
                u32x4 f2w; f2w.x = pk2(u.x, u.y); f2w.y = pk2(u.z, u.w); f2w.z = vq.x; f2w.w = vq.y; const bf16x8 f2 = __builtin_bit_cast(bf16x8, f2w);
                f32x4 y = __builtin_amdgcn_mfma_f32_16x16x32_bf16(ay0, sf0, zero4, 0, 0, 0); y = __builtin_amdgcn_mfma_f32_16x16x32_bf16(ay1, sf1, y, 0, 0, 0); y = __builtin_amdgcn_mfma_f32_16x16x32_bf16(ay2, f2, y, 0, 0, 0);
#pragma unroll
                for (int i = 0; i < 4; ++i) YB[(tokg + i) * 512 + h * 64 + v] = y[i];
#pragma unroll
                for (int n = 0; n < 4; ++n) { const bf16x8 as = *(const LAS bf16x8*)(slot + WY_AS + n * 1024 + fo); ST[vt][n] = __builtin_amdgcn_mfma_f32_16x16x32_bf16(as, f2, ST[vt][n] * PT4[n], 0, 0, 0); }
            }
            asm volatile("s_waitcnt lgkmcnt(0)" ::: "memory");
            if (lane == 0) __hip_atomic_store(flags + 8 + wave, c + 1, __ATOMIC_RELEASE, __HIP_MEMORY_SCOPE_WORKGROUP);
        }
    }
    __syncthreads();
}
struct PostIn { u32x4 ya, gate, vc, vp, rc, rp, kc, kp, al; f32x4 y0, y1; };
__device__ __forceinline__ void mixpost_load(PostIn& m, const bf16* YC, const float* YB, const bf16* PR, const bf16* AL, int row, int lane) {
    m.ya = *(const u32x4*)(YC + (size_t)row * DM + 8 * lane); m.gate = *(const u32x4*)(YC + (size_t)row * DM + 512 + 8 * lane);
    m.y0 = *(const f32x4*)(YB + (size_t)row * 512 + 8 * lane); m.y1 = *(const f32x4*)(YB + (size_t)row * 512 + 8 * lane + 4);
    const bool hp = (row & (SEQ - 1)) != 0; const size_t rp = hp ? (size_t)(row - 1) : (size_t)row;
    m.rc = *(const u32x4*)(PR + (size_t)row * 1792 + 8 * lane); m.kc = *(const u32x4*)(PR + (size_t)row * 1792 + 512 + 8 * lane); m.vc = *(const u32x4*)(PR + (size_t)row * 1792 + 1024 + 8 * lane);
    m.rp = *(const u32x4*)(PR + rp * 1792 + 8 * lane); m.kp = *(const u32x4*)(PR + rp * 1792 + 512 + 8 * lane); m.vp = *(const u32x4*)(PR + rp * 1792 + 1024 + 8 * lane);
    if (!hp) { m.rp = (u32x4){0u, 0u, 0u, 0u}; m.kp = m.rp; m.vp = m.rp; }
    m.al = *(const u32x4*)(AL + (size_t)row * 512 + 8 * lane);
}
__device__ __forceinline__ void mixpost_compute(const PostIn& m, const Args& a, bf16* YC, int row, int lane) {
    const float* ga = (const float*)a.in[15] + 8 * lane; const float* lw = (const float*)a.in[25] + 8 * lane; const float* lb = (const float*)a.in[26] + 8 * lane;
    const float* mr = (const float*)a.in[16] + 8 * lane; const float* mk = mr + 512; const float* mv = mr + 1024; const float* kap = (const float*)a.in[23] + 8 * lane; const float* rkp = (const float*)a.in[24] + 8 * lane;
    float f[8]; unpack8(m.ya, f); float s = 0.f;
#pragma unroll
    for (int e = 0; e < 8; ++e) s += f[e] * f[e];
    const float y[8] = {m.y0.x, m.y0.y, m.y0.z, m.y0.w, m.y1.x, m.y1.y, m.y1.z, m.y1.w}; float s1 = 0.f, s2 = 0.f;
#pragma unroll
    for (int e = 0; e < 8; ++e) { s1 += y[e]; s2 += y[e] * y[e]; }
    float rc[8], rp[8], kc[8], kp[8], al[8], vc[8], vp[8], gg[8]; unpack8(m.rc, rc); unpack8(m.rp, rp); unpack8(m.kc, kc); unpack8(m.kp, kp); unpack8(m.al, al); unpack8(m.vc, vc); unpack8(m.vp, vp); unpack8(m.gate, gg);
    float cs = 0.f;
#pragma unroll
    for (int e = 0; e < 8; ++e) { const float r = rc[e] + (rp[e] - rc[e]) * mr[e], kx = kc[e] + (kp[e] - kc[e]) * mk[e]; cs += r * kx * (1.f + (al[e] - 1.f) * kap[e]) * rkp[e]; }
#pragma unroll
    for (int o = 1; o < 64; o <<= 1) { s += __shfl_xor(s, o); if (o < 8) { s1 += __shfl_xor(s1, o); s2 += __shfl_xor(s2, o); cs += __shfl_xor(cs, o); } }
    const float rinv = rsqrtf(s * (1.f / 512.f) + 1e-6f);
    { u32x4 o; o.x = pk2(f[0] * rinv * ga[0], f[1] * rinv * ga[1]); o.y = pk2(f[2] * rinv * ga[2], f[3] * rinv * ga[3]); o.z = pk2(f[4] * rinv * ga[4], f[5] * rinv * ga[5]); o.w = pk2(f[6] * rinv * ga[6], f[7] * rinv * ga[7]); *(u32x4*)(YC + (size_t)row * DM + 8 * lane) = o; }
    const float mean = s1 * (1.f / 64.f), var = fmaxf(s2 * (1.f / 64.f) - mean * mean, 0.f), rstd = rsqrtf(var + 64e-5f);
    float o[8];
#pragma unroll
    for (int e = 0; e < 8; ++e) { const float v = vc[e] + (vp[e] - vc[e]) * mv[e]; o[e] = ((y[e] - mean) * rstd * lw[e] + lb[e] + cs * v) * gg[e]; }
    u32x4 w; w.x = pk2(o[0], o[1]); w.y = pk2(o[2], o[3]); w.z = pk2(o[4], o[5]); w.w = pk2(o[6], o[7]); *(u32x4*)(YC + (size_t)row * DM + 512 + 8 * lane) = w;
}
__device__ __forceinline__ void phase_mixpost(const Args& a, int lane, int gw, int NGW) {
    unsigned char* ws = a.ws; bf16* YC = (bf16*)(ws + WS_U); const float* YB = (const float*)(ws + WS_YB); const bf16* PR = (const bf16*)(ws + WS_PRW); const bf16* AL = (const bf16*)(ws + WS_AL);
    for (int row = gw; row < MT; row += 2 * NGW) { const int row2 = row + NGW; const bool has2 = row2 < MT;
        PostIn A, B; mixpost_load(A, YC, YB, PR, AL, row, lane); mixpost_load(B, YC, YB, PR, AL, has2 ? row2 : row, lane);
        mixpost_compute(A, a, YC, row, lane); if (has2) mixpost_compute(B, a, YC, row2, lane); }
}
#define XB_TMO      128
#define XB_XCNT(j)  (256  + 64 * (j))
#define XB_XSUB(j)  (1280 + 64 * (j))
#define XB_XGEN(j)  (2304 + 64 * (j))
#define XB_TOP      3328
#define XB_TOPGEN   3392
#define XCD_BAR_WORDS 3456
#define XB_SPIN_CAP (1u << 18)

__device__ __forceinline__ unsigned xb_ld(unsigned* p)              { return __hip_atomic_load(p, __ATOMIC_RELAXED, __HIP_MEMORY_SCOPE_AGENT); }
__device__ __forceinline__ unsigned xb_add(unsigned* p, unsigned v) { return __hip_atomic_fetch_add(p, v, __ATOMIC_RELAXED, __HIP_MEMORY_SCOPE_AGENT); }
__device__ __forceinline__ unsigned xb_xcc_id() { return (unsigned)__builtin_amdgcn_s_getreg((3 << 11) | 20) & 0xFu; }
#define XB_SPIN(cond, bar) do { unsigned _sp = 0; while (cond) { __builtin_amdgcn_s_sleep(1); \
    if ((++_sp & 255u) == 0u) { if (xb_ld(&(bar)[XB_TMO])) break; if (_sp > XB_SPIN_CAP) { atomicAdd(&(bar)[XB_TMO], 1u); break; } } } } while (0)

struct XcdBarrier {
    unsigned* bar; unsigned x;
    volatile LAS unsigned* st;
};

__device__ __forceinline__ XcdBarrier xcd_barrier_post(unsigned* bar, volatile LAS unsigned* st) {
    XcdBarrier b; b.bar = bar; b.x = xb_xcc_id(); b.st = st;
    if (threadIdx.x == 0) (void)xb_add(&bar[XB_XCNT(b.x)], 1u);
    return b;
}
__device__ __forceinline__ void xcd_barrier_complete(unsigned* bar, unsigned x, unsigned& nloc, unsigned& nx) {
    const unsigned G = gridDim.x * gridDim.y * gridDim.z;
    unsigned sum, cnt, mine, sp = 0u;
    for (;;) {
        sum = 0u; cnt = 0u; mine = 0u;
#pragma unroll
        for (unsigned j = 0; j < 16; ++j) { const unsigned c = xb_ld(&bar[XB_XCNT(j)]); sum += c; cnt += (c > 0u) ? 1u : 0u; mine = (j == x) ? c : mine; }
        if (sum == G) break;
        __builtin_amdgcn_s_sleep(1);
        if ((++sp & 255u) == 0u) { if (xb_ld(&bar[XB_TMO])) break; if (sp > XB_SPIN_CAP) { atomicAdd(&bar[XB_TMO], 1u); break; } }
    }
    nloc = mine > 0u ? mine : 1u; nx = cnt > 0u ? cnt : 1u;
}

__device__ __forceinline__ void xcd_barrier(const XcdBarrier& b) {
    asm volatile("s_waitcnt vmcnt(0)" ::: "memory");
    __syncthreads();
    if (threadIdx.x == 0) {
        unsigned* bar = b.bar;
        __builtin_amdgcn_s_waitcnt(0);
        unsigned nloc = b.st[0], nx = b.st[1];
        if (nloc == 0u) { xcd_barrier_complete(bar, b.x, nloc, nx); b.st[0] = nloc; b.st[1] = nx; }
        const unsigned old = xb_add(&bar[XB_XSUB(b.x)], 1u);
        const unsigned gen = old / nloc;
        if (old + 1u == (gen + 1u) * nloc) {
            __builtin_amdgcn_fence(__ATOMIC_RELEASE, "agent");
            asm volatile("s_waitcnt vmcnt(0)" ::: "memory");
            const unsigned og = xb_add(&bar[XB_TOP], 1u);
            const unsigned tg = og / nx;
            if (og + 1u == (tg + 1u) * nx) xb_add(&bar[XB_TOPGEN], 1u);
            else XB_SPIN(xb_ld(&bar[XB_TOPGEN]) == tg, bar);
            __builtin_amdgcn_fence(__ATOMIC_ACQUIRE, "agent");
            xb_add(&bar[XB_XGEN(b.x)], 1u);
            asm volatile("s_waitcnt vmcnt(0)" ::: "memory");
        } else {
            XB_SPIN(xb_ld(&bar[XB_XGEN(b.x)]) == gen, bar);
            __builtin_amdgcn_fence(__ATOMIC_ACQUIRE, "agent");
            asm volatile("s_waitcnt vmcnt(0)" ::: "memory");
        }
    }
    __syncthreads();
}

__global__ void __launch_bounds__(512, 2) mk_fwd(Args a) {
    extern __shared__ __attribute__((aligned(16))) unsigned char lds_raw[];
    LAS unsigned char* lds = (LAS unsigned char*)lds_raw;
    cg::grid_group grid = cg::this_grid();
    int tid = threadIdx.x, lane = tid & 63, wave = __builtin_amdgcn_readfirstlane(tid >> 6);
    const int G = gridDim.x; int gw = blockIdx.x * 8 + wave; const int NGW = G * 8;
#define RELAUNDER() do { tid = threadIdx.x; asm volatile("" : "+v"(tid)); lane = tid & 63; wave = __builtin_amdgcn_readfirstlane(tid >> 6); gw = blockIdx.x * 8 + wave; } while (0)
    unsigned char* ws = a.ws;
    const float* x = (const float*)a.in[0]; float* hbuf = a.out;
    const float* MOD = (const float*)(ws + WS_MOD);
    bf16* U = (bf16*)(ws + WS_U); bf16* ACT = (bf16*)(ws + WS_ACT);
    using pg8::Gemm; using pg8::StaticOrder;

#ifndef ONLY
#define ONLY -1
#endif
#define PH(n) (ONLY < 0 || ONLY == (n))
#ifndef SKIPMASK
#define SKIPMASK 0
#endif
#ifndef DUP
#define DUP -1
#endif
#define REP(n) for (int rep_ = 0; rep_ < ((DUP == (n)) ? 2 : 1); ++rep_)
    unsigned* barw = (unsigned*)(ws + WS_BAR);
    if (blockIdx.x == 0) for (int i = threadIdx.x; i < XCD_BAR_WORDS; i += 512) barw[i] = 0u;
    volatile LAS unsigned* bst = (volatile LAS unsigned*)(lds + LDS_BYTES - 32);
    if (threadIdx.x < 2) bst[threadIdx.x] = 0u;
    __syncthreads();
    if (PH(0)) REP(0) {
    if (blockIdx.x == 0 && threadIdx.x == 0) { *(unsigned*)(a.ws + WS_CTR) = 0u; *((unsigned*)(a.ws + WS_CTR) + 64) = 0u; }
    phase_prologue(a, lds, tid, lane, wave); }
    grid.sync(); RELAUNDER();
    XcdBarrier xbar = xcd_barrier_post(barw, bst);
#if DUP == 99
    for (int i_ = 0; i_ < 16; ++i_) xcd_barrier(xbar);
#endif
    if (PH(1)) REP(1)
    phase_normmod(x, (const float*)a.in[5], MOD, 0, 1024, U, lane, gw, NGW);
    xcd_barrier(xbar); RELAUNDER();
    if (PH(2))
    REP(2)
    { Gemm g{U, (const bf16*)(ws + WS_WGU1), MT, 2 * FF, DM}; StaticOrder S; S.init(MT, 2 * FF, G, (int)blockIdx.x); pg8::EpiSwiglu E{ACT, FF};
      pg8::gemm_phase<pg8::EpiSwiglu, StaticOrder, true, true>(lds, g, S, E); }
    xcd_barrier(xbar); RELAUNDER();
    if (PH(3)) REP(3)
    { Gemm g{ACT, (const bf16*)(ws + WS_WD1), MT, DM, FF}; StaticOrder S; S.init(MT, DM, G, (int)blockIdx.x); pg8::EpiResid E{x, hbuf, MOD + 2048, 0.5f};
      pg8::gemm_phase<pg8::EpiResid, StaticOrder, true, true>(lds, g, S, E); }
    xcd_barrier(xbar); RELAUNDER();
    if (PH(1))
    phase_normmod(hbuf, (const float*)a.in[9], MOD, 3072, 4096, U, lane, gw, NGW);
    xcd_barrier(xbar); RELAUNDER();
    if (PH(5)) REP(5)
    { Gemm g{U, (const bf16*)(ws + WS_WIN), MT, 2560, DM}; StaticOrder S; S.init(MT, 2560, G, (int)blockIdx.x); pg8::EpiProj E{(bf16*)(ws + WS_PMLA), (bf16*)(ws + WS_PRW)};
      pg8::gemm_phase<pg8::EpiProj, StaticOrder, true, true>(lds, g, S, E); }
    xcd_barrier(xbar); RELAUNDER();
    if (PH(6)) REP(6)
    phase_mixprep(a, lane, gw, NGW);
    xcd_barrier(xbar); RELAUNDER();
    {
    if (PH(7)) REP(71)
    { Gemm g{(const bf16*)(ws + WS_QN), (const bf16*)(ws + WS_WUQ), MT, 768, 384 + (G >> 20)}; StaticOrder S; S.init(MT, 768, G, (int)blockIdx.x); pg8::EpiQ E{(bf16*)(ws + WS_QB), (const float*)(ws + WS_CS), 0.07216878364870322f * 1.4426950408889634f};
      pg8::gemm_phase<pg8::EpiQ, StaticOrder, true, true>(lds, g, S, E); }
    if (PH(8)) REP(72)
    { Gemm g{(const bf16*)(ws + WS_KVN), (const bf16*)(ws + WS_WK), MT, 512, 256 + (G >> 20)}; StaticOrder S; S.init(MT, 512, G, (int)blockIdx.x); pg8::EpiPlain E{(bf16*)(ws + WS_KN), 512};
      pg8::gemm_phase<pg8::EpiPlain, StaticOrder, true, true>(lds, g, S, E); }
    if (PH(9)) REP(73)
    { Gemm g{(const bf16*)(ws + WS_WV), (const bf16*)(ws + WS_KVN), 512, MT, 256 + (G >> 20)}; StaticOrder S; S.init(512, MT, G, (int)blockIdx.x); pg8::EpiVT E{(bf16*)(ws + WS_VT), (size_t)MT};
      pg8::gemm_phase<pg8::EpiVT, StaticOrder, true, true>(lds, g, S, E); }
    if (PH(10)) REP(74)
    { Gemm g{(const bf16*)(ws + WS_LIN), (const bf16*)(ws + WS_WLORA), MT, 1536, 256 + (G >> 20)}; StaticOrder S; S.init(MT, 1536, G, (int)blockIdx.x); pg8::EpiLora E{(float*)(ws + WS_DEC), (bf16*)(ws + WS_AL), U, (const float*)a.in[17], (const float*)a.in[19]};
      pg8::gemm_phase<pg8::EpiLora, StaticOrder, true, true>(lds, g, S, E); }
    }
    xcd_barrier(xbar); RELAUNDER();
    if (PH(11)) REP(30) {
        unsigned* qctr = (unsigned*)(ws + WS_CTR) + 64 * rep_;
        REP(21)
        for (int bh = blockIdx.x; bh < 64; bh += G) { rw_wy(a, lds, bh, tid); }
        volatile LAS unsigned* qslot = (volatile LAS unsigned*)(lds + LDS_BYTES - 16);
        for (;;) {
            if (tid == 0) *qslot = atomicAdd(qctr, 1u);
            __syncthreads();
            const unsigned idx = *qslot;
            if (idx >= 1024u) break;
            const int u = 31 - (int)(idx >> 5), bh = (int)(idx & 31u);
            attn_unit((const bf16*)(ws + WS_QB), (const bf16*)(ws + WS_KN), (const bf16*)(ws + WS_KR), (const bf16*)(ws + WS_VT), U, lds, bh >> 2, bh & 3, u, tid, lane, wave);
        }
    }
    xcd_barrier(xbar); RELAUNDER();
    if (PH(13)) phase_mixpost(a, lane, gw, NGW);
    xcd_barrier(xbar); RELAUNDER();
    if (PH(3))
    { Gemm g{U, (const bf16*)(ws + WS_WOUT), MT, DM, DM}; StaticOrder S; S.init(MT, DM, G, (int)blockIdx.x); pg8::EpiResid E{hbuf, hbuf, MOD + 5120, 1.0f};
      pg8::gemm_phase<pg8::EpiResid, StaticOrder, true, true>(lds, g, S, E); }
    xcd_barrier(xbar); RELAUNDER();
    if (PH(1))
    phase_normmod(hbuf, (const float*)a.in[28], MOD, 6144, 7168, U, lane, gw, NGW);
    xcd_barrier(xbar); RELAUNDER();
    if (PH(2))
    { Gemm g{U, (const bf16*)(ws + WS_WGU2), MT, 2 * FF, DM}; StaticOrder S; S.init(MT, 2 * FF, G, (int)blockIdx.x); pg8::EpiSwiglu E{ACT, FF};
      pg8::gemm_phase<pg8::EpiSwiglu, StaticOrder, true, true>(lds, g, S, E); }
    xcd_barrier(xbar); RELAUNDER();
    if (PH(3))
    { Gemm g{ACT, (const bf16*)(ws + WS_WD2), MT, DM, FF}; StaticOrder S; S.init(MT, DM, G, (int)blockIdx.x); pg8::EpiResid E{hbuf, hbuf, MOD + 8192, 0.5f};
      pg8::gemm_phase<pg8::EpiResid, StaticOrder, true, true>(lds, g, S, E); }
    xcd_barrier(xbar); RELAUNDER();
    if (PH(15))
    phase_finalnorm(hbuf, (const float*)a.in[32], lane, gw, NGW);
}

extern "C" void kernel_launch(void* const* d_in, const int* in_sizes, int n_in, void* d_out, int out_size, void* d_ws, size_t ws_size, hipStream_t stream) {
    static int grid = 0;
    if (grid == 0) {
        int dev = 0, cus = 0, per_cu = 0;
        hipGetDevice(&dev); hipDeviceGetAttribute(&cus, hipDeviceAttributeMultiprocessorCount, dev);
        if (hipFuncSetAttribute((const void*)mk_fwd, hipFuncAttributeMaxDynamicSharedMemorySize, LDS_BYTES) != hipSuccess) { fprintf(stderr, "kernel_launch: hipFuncSetAttribute failed\n"); grid = -1; return; }
        if (hipOccupancyMaxActiveBlocksPerMultiprocessor(&per_cu, (const void*)mk_fwd, 512, LDS_BYTES) != hipSuccess || per_cu < 1) { fprintf(stderr, "kernel_launch: occupancy query gave %d\n", per_cu); per_cu = 1; }
        (void)hipGetLastError();
        grid = cus * per_cu;
        if (n_in != 33 || ws_size < (size_t)990 * MiB) { fprintf(stderr, "kernel_launch: unexpected n_in %d / ws %zu\n", n_in, ws_size); grid = -1; return; }
    }
    if (grid < 0) return;
    Args a{};
    for (int i = 0; i < 33; ++i) a.in[i] = d_in[i];
    a.out = (float*)d_out; a.ws = (unsigned char*)d_ws;
    void* args[] = {&a};
    hipError_t e = hipLaunchCooperativeKernel((const void*)mk_fwd, dim3(grid), dim3(512), args, LDS_BYTES, stream);
    if (e != hipSuccess) fprintf(stderr, "cooperative launch failed: %s (grid %d)\n", hipGetErrorString(e), grid);
}
```

```cpp
#include <hip/hip_runtime.h>
#include <hip/hip_cooperative_groups.h>
#include <cstdio>
#include <cstdint>
namespace cg = cooperative_groups;
namespace pg8 {
#define PG8_LAS __attribute__((address_space(3)))
typedef unsigned short bf16_t;
typedef short bf16x8 __attribute__((ext_vector_type(8)));
typedef float f32x4 __attribute__((ext_vector_type(4)));
typedef unsigned u32x4 __attribute__((ext_vector_type(4)));
constexpr int BM = 256, BK = 64, HALF = 128, HTB = HALF * BK * 2  , STAGE_BYTES = 8 * HTB, NXCD = 8, WGM = 8;

__host__ __device__ __forceinline__ int lds_byte(int r, int c) { const int st = (r >> 4) * 2 + (c >> 5), rr = r & 15, cc = c & 31, ob = rr * 64 + cc * 2; return st * 1024 + (ob ^ (((ob >> 9) & 1) << 5)); }
__host__ __device__ __forceinline__ void stage_rc(int b, int& R, int& C) { const int st = b / 1024, sb = b % 1024, swz = sb ^ (((sb >> 9) & 1) << 5); R = (st >> 1) * 16 + swz / 64; C = (st & 1) * 32 + (swz % 64) / 2; }
__host__ __device__ __forceinline__ int perm32(int rho) { const int n = rho >> 4, i = rho & 15; return 8 * (i >> 2) + 4 * n + (i & 3); }

struct Unit { int pm, pn; };
struct Gemm { const bf16_t* A; const bf16_t* Bt; int M, N, K; };

struct StaticOrder {
    int nM, nN, nwg, G, c;
    __host__ __device__ void init(int M, int N, int G_, int c_) { nM = M / BM; nN = N / BM; nwg = nM * nN; G = G_; c = c_; }
    __host__ __device__ bool next(int i, Unit& u) const {
        const long L = (long)i * G + c; if (L >= nwg) return false;
        int wgid = (int)L; { const int q = nwg / NXCD, r = nwg % NXCD, xcd = wgid % NXCD, off = wgid / NXCD; wgid = (xcd < r ? xcd * (q + 1) : r * (q + 1) + (xcd - r) * q) + off; }
        const int nig = WGM * nN, gid = wgid / nig, fm = gid * WGM, gsz = (nM - fm) < WGM ? (nM - fm) : WGM;
        u.pm = fm + ((wgid % nig) % gsz); u.pn = (wgid % nig) / gsz; return true;
    }
    __device__ __forceinline__ void a_ready(const Unit&) const {}
    __device__ __forceinline__ void done(const Unit&) const {}
};

__device__ __forceinline__ unsigned cvt_pk_bf16(float lo, float hi) { unsigned r; asm volatile("v_cvt_pk_bf16_f32 %0, %1, %2" : "=v"(r) : "v"(lo), "v"(hi)); return r; }
typedef float f32x2 __attribute__((ext_vector_type(2)));
__device__ __forceinline__ unsigned pkbf(float a, float b) { typedef __bf16 bf2_t __attribute__((ext_vector_type(2))); f32x2 v = {a, b}; return __builtin_bit_cast(unsigned, __builtin_convertvector(v, bf2_t)); }
typedef unsigned u32x2 __attribute__((ext_vector_type(2)));

struct EpiSwiglu {
    static constexpr bool PERM = true, AFTER_DRAIN = false;
    bf16_t* O; int ldo;
    __device__ __forceinline__ void operator()(const f32x4 (&acc)[2][2][4][2], const Unit& u, int wr, int wc, int fr, int fq) const {
        const int row0 = u.pm * BM + wr * 64 + fr, col0 = u.pn * 128 + wc * 32 + 8 * fq;
#pragma unroll
        for (int ai = 0; ai < 2; ++ai)
#pragma unroll
            for (int m = 0; m < 4; ++m) { bf16_t* rowp = O + (size_t)(row0 + ai * HALF + m * 16) * ldo + col0; float v[8];
#pragma unroll
                for (int bj = 0; bj < 2; ++bj) { const f32x4 g = acc[ai][bj][m][0], up = acc[ai][bj][m][1];
#pragma unroll
                    for (int e = 0; e < 4; ++e) v[4 * bj + e] = g[e] * __builtin_amdgcn_rcpf(1.f + __expf(-g[e])) * up[e]; }
                u32x4 w; w.x = pkbf(v[0], v[1]); w.y = pkbf(v[2], v[3]); w.z = pkbf(v[4], v[5]); w.w = pkbf(v[6], v[7]); *(u32x4*)rowp = w; }
    }
};
struct EpiResid {
    static constexpr bool PERM = false, AFTER_DRAIN = false;
    const float* base; float* out; const float* gate; float gs;
    __device__ __forceinline__ void operator()(const f32x4 (&acc)[2][2][4][2], const Unit& u, int wr, int wc, int fr, int fq) const {
        const int b = (u.pm * BM) >> 13; const float* gp = gate + (size_t)b * 9216;
        const int row0 = u.pm * BM + wr * 64 + fr, col0 = u.pn * BM + wc * 32 + 4 * fq;
        f32x4 gv[2][2];
#pragma unroll
        for (int bj = 0; bj < 2; ++bj)
#pragma unroll
            for (int n = 0; n < 2; ++n) gv[bj][n] = *(const f32x4*)(gp + col0 + bj * HALF + n * 16) * gs;
#pragma unroll
        for (int ai = 0; ai < 2; ++ai)
#pragma unroll
            for (int m = 0; m < 4; ++m) { const size_t off = (size_t)(row0 + ai * HALF + m * 16) * 1024 + col0;
#pragma unroll
                for (int bj = 0; bj < 2; ++bj)
#pragma unroll
                    for (int n = 0; n < 2; ++n) { const f32x4 bs = *(const f32x4*)(base + off + bj * HALF + n * 16); *(f32x4*)(out + off + bj * HALF + n * 16) = bs + gv[bj][n] * acc[ai][bj][m][n]; } }
    }
};
__device__ __forceinline__ void store8bf(bf16_t* p, const f32x4 v0, const f32x4 v1) { u32x4 w; w.x = pkbf(v0[0], v0[1]); w.y = pkbf(v0[2], v0[3]); w.z = pkbf(v1[0], v1[1]); w.w = pkbf(v1[2], v1[3]); *(u32x4*)p = w; }
struct EpiPlain {
    static constexpr bool PERM = true, AFTER_DRAIN = false;
    bf16_t* O; int ldc;
    __device__ __forceinline__ void operator()(const f32x4 (&acc)[2][2][4][2], const Unit& u, int wr, int wc, int fr, int fq) const {
        const int row0 = u.pm * BM + wr * 64 + fr, col0 = u.pn * BM + wc * 32 + 8 * fq;
#pragma unroll
        for (int ai = 0; ai < 2; ++ai)
#pragma unroll
            for (int m = 0; m < 4; ++m) { bf16_t* rowp = O + (size_t)(row0 + ai * HALF + m * 16) * ldc + col0;
#pragma unroll
                for (int bj = 0; bj < 2; ++bj) store8bf(rowp + bj * HALF, acc[ai][bj][m][0], acc[ai][bj][m][1]); }
    }
};
struct EpiProj {
    static constexpr bool PERM = true, AFTER_DRAIN = false;
    bf16_t* Pm; bf16_t* Pr;
    __device__ __forceinline__ void operator()(const f32x4 (&acc)[2][2][4][2], const Unit& u, int wr, int wc, int fr, int fq) const {
        bf16_t* bp; int ld, colt; if (u.pn < 3) { bp = Pm; ld = 768; colt = u.pn * BM; } else { bp = Pr; ld = 1792; colt = (u.pn - 3) * BM; }
        const int row0 = u.pm * BM + wr * 64 + fr, col0 = colt + wc * 32 + 8 * fq;
#pragma unroll
        for (int ai = 0; ai < 2; ++ai)
#pragma unroll
            for (int m = 0; m < 4; ++m) { bf16_t* rowp = bp + (size_t)(row0 + ai * HALF + m * 16) * ld + col0;
#pragma unroll
                for (int bj = 0; bj < 2; ++bj) store8bf(rowp + bj * HALF, acc[ai][bj][m][0], acc[ai][bj][m][1]); }
    }
};
struct EpiQ {
    static constexpr bool PERM = true, AFTER_DRAIN = false;
    bf16_t* O; const float* cs; float scale;
    __device__ __forceinline__ void operator()(const f32x4 (&acc)[2][2][4][2], const Unit& u, int wr, int wc, int fr, int fq) const {
        const int row0 = u.pm * BM + wr * 64 + fr, col0 = u.pn * BM + wc * 32 + 8 * fq;
#pragma unroll
        for (int bj = 0; bj < 2; ++bj) { const int c = col0 + bj * HALF, p = c % 192; const bool rope = p >= 128; const int j4 = ((p - 128) >> 3) * 4;
#pragma unroll
            for (int ai = 0; ai < 2; ++ai)
#pragma unroll
                for (int m = 0; m < 4; ++m) { const int row = row0 + ai * HALF + m * 16; f32x4 v0 = acc[ai][bj][m][0], v1 = acc[ai][bj][m][1];
                    if (rope) { const f32x4 cv = *(const f32x4*)(cs + (size_t)row * 64 + j4), sv = *(const f32x4*)(cs + (size_t)row * 64 + 32 + j4);
                        const f32x4 a = v0 * cv - v1 * sv, b2 = v1 * cv + v0 * sv; v0 = a; v1 = b2; }
                    store8bf(O + (size_t)row * 768 + c, v0 * scale, v1 * scale); } }
    }
};
struct EpiVT {
    static constexpr bool PERM = true, AFTER_DRAIN = false;
    bf16_t* O; size_t ldo;
    __device__ __forceinline__ void operator()(const f32x4 (&acc)[2][2][4][2], const Unit& u, int wr, int wc, int fr, int fq) const {
        const int row0 = u.pm * BM + wr * 64 + fr, col0 = u.pn * BM + wc * 32 + 8 * fq;
#pragma unroll
        for (int ai = 0; ai < 2; ++ai)
#pragma unroll
            for (int m = 0; m < 4; ++m) { bf16_t* rowp = O + (size_t)(row0 + ai * HALF + m * 16) * ldo;
#pragma unroll
                for (int bj = 0; bj < 2; ++bj)
#pragma unroll
                    for (int n = 0; n < 2; ++n) { const int c = col0 + bj * HALF + 4 * n, q4 = (c & 15) >> 2, pq = (q4 == 1) ? 2 : ((q4 == 2) ? 1 : q4), dst = (c & ~15) + 4 * pq;
                        const f32x4 v = acc[ai][bj][m][n]; u32x2 w; w.x = pkbf(v[0], v[1]); w.y = pkbf(v[2], v[3]); *(u32x2*)(rowp + dst) = w; } }
    }
};
struct EpiLora {
    static constexpr bool PERM = true, AFTER_DRAIN = false;
    float* DEC; bf16_t* AL; bf16_t* YC; const float* w0; const float* a0;
    __device__ __forceinline__ void operator()(const f32x4 (&acc)[2][2][4][2], const Unit& u, int wr, int wc, int fr, int fq) const {
        const int sect = u.pn >> 1; const int row0 = u.pm * BM + wr * 64 + fr, col0 = (u.pn & 1) * BM + wc * 32 + 8 * fq;
#pragma unroll
        for (int bj = 0; bj < 2; ++bj) { const int c = col0 + bj * HALF;
            f32x4 b0 = {0.f, 0.f, 0.f, 0.f}, b1 = b0;
            if (sect == 0) { b0 = *(const f32x4*)(w0 + c); b1 = *(const f32x4*)(w0 + c + 4); } else if (sect == 1) { b0 = *(const f32x4*)(a0 + c); b1 = *(const f32x4*)(a0 + c + 4); }
#pragma unroll
            for (int ai = 0; ai < 2; ++ai)
#pragma unroll
                for (int m = 0; m < 4; ++m) { const int row = row0 + ai * HALF + m * 16; f32x4 v0 = acc[ai][bj][m][0] + b0, v1 = acc[ai][bj][m][1] + b1;
                    if (sect == 0) {
#pragma unroll
                        for (int e = 0; e < 4; ++e) { { const float z = -v0[e]; const float sp = fmaxf(z, 0.f) + __logf(1.f + __expf(-fabsf(z))); v0[e] = __expf(-__expf(-sp - 0.5f)); }
                                                      { const float z = -v1[e]; const float sp = fmaxf(z, 0.f) + __logf(1.f + __expf(-fabsf(z))); v1[e] = __expf(-__expf(-sp - 0.5f)); } }
                        *(f32x4*)(DEC + (size_t)row * 512 + c) = v0; *(f32x4*)(DEC + (size_t)row * 512 + c + 4) = v1;
                    } else if (sect == 1) {
#pragma unroll
                        for (int e = 0; e < 4; ++e) { v0[e] = __builtin_amdgcn_rcpf(1.f + __expf(-v0[e])); v1[e] = __builtin_amdgcn_rcpf(1.f + __expf(-v1[e])); }
                        store8bf(AL + (size_t)row * 512 + c, v0, v1);
                    } else store8bf(YC + (size_t)row * 1024 + 512 + c, v0, v1);
                } }
    }
};
template <class Epi, class Sched, bool ALIGN_EPI = false, bool SP2 = false>
__device__ __forceinline__ void gemm_phase(PG8_LAS unsigned char* lds, const Gemm g, const Sched& S, const Epi& E) {
    int tid_l = threadIdx.x; asm volatile("" : "+v"(tid_l));
    const int tid = tid_l, wid = __builtin_amdgcn_readfirstlane(tid >> 6), lane = tid & 63, wr = wid >> 2, wc = wid & 3, fr = lane & 15, fq = lane >> 4;
    const int K = g.K, nt = K / BK;
    unsigned voffA[2], voffB[2];
#pragma unroll
    for (int i = 0; i < 2; ++i) { int R, C; stage_rc(tid * 16 + i * 8192, R, C); const int Rb = Epi::PERM ? ((R & ~31) + perm32(R & 31)) : R;
        voffA[i] = (unsigned)(R * K + C) * 2u; voffB[i] = (unsigned)(Rb * K + C) * 2u; }
    const size_t kstep = (size_t)(BK * 2);
    const size_t hstep = (size_t)HALF * K * 2;
    const size_t tstep = 2 * hstep;
    const unsigned ldsw = (unsigned)wid * 1024u;
    const int aoff = lds_byte(wr * 64 + fr, fq * 8), boff = lds_byte(wc * 32 + fr, fq * 8);
#define PG8_SA(b, h) (((b) * 2 + (h)) * HTB)
#define PG8_SB(b, h) ((4 + (b) * 2 + (h)) * HTB)
#define PG8_STAGE(bufoff, gbase, voff) do { _Pragma("unroll") for (int _i = 0; _i < 2; ++_i) \
        __builtin_amdgcn_global_load_lds((const unsigned*)((const char*)(gbase) + (voff)[_i]), (PG8_LAS unsigned*)(lds + (bufoff) + ldsw + _i * 8192), 16, 0, 0); } while (0)
#define PG8_LDA(dst, b, h) do { _Pragma("unroll") for (int m = 0; m < 4; ++m) _Pragma("unroll") for (int k = 0; k < 2; ++k) dst[m][k] = *(const PG8_LAS bf16x8*)(lds + PG8_SA(b, h) + aoff + m * 2048 + k * 1024); } while (0)
#define PG8_LDB(dst, b, h) do { _Pragma("unroll") for (int n = 0; n < 2; ++n) _Pragma("unroll") for (int k = 0; k < 2; ++k) dst[n][k] = *(const PG8_LAS bf16x8*)(lds + PG8_SB(b, h) + boff + n * 2048 + k * 1024); } while (0)
#define PG8_MMA(ai, bj, At, Bt) do { __builtin_amdgcn_s_setprio(1); _Pragma("unroll") for (int m = 0; m < 4; ++m) _Pragma("unroll") for (int n = 0; n < 2; ++n) _Pragma("unroll") for (int k = 0; k < 2; ++k) \
        acc[ai][bj][m][n] = __builtin_amdgcn_mfma_f32_16x16x32_bf16(Bt[n][k], At[m][k], acc[ai][bj][m][n], 0, 0, 0); __builtin_amdgcn_s_setprio(0); } while (0)
#define PG8_WAIT_V(n) asm volatile("s_waitcnt vmcnt(" #n ")" ::: "memory")
#define PG8_WAIT_L(n) asm volatile("s_waitcnt lgkmcnt(" #n ")" ::: "memory")
#define PG8_BAR __builtin_amdgcn_s_barrier()
#define PG8_SCHED __builtin_amdgcn_sched_barrier(0)
    Unit cur, nxt; int ui = 0;
    if (!S.next(0, cur)) return;
    f32x4 acc[2][2][4][2];
#pragma unroll
    for (int a = 0; a < 2; ++a)
#pragma unroll
        for (int b = 0; b < 2; ++b)
#pragma unroll
            for (int m = 0; m < 4; ++m)
#pragma unroll
                for (int n = 0; n < 2; ++n) acc[a][b][m][n] = (f32x4){0.f, 0.f, 0.f, 0.f};
    bf16x8 At[4][2], B0[2][2], B1[2][2];
    const char* cA = (const char*)g.A + (size_t)cur.pm * tstep; const char* cB = (const char*)g.Bt + (size_t)cur.pn * tstep;
    S.a_ready(cur);
    if constexpr (SP2) {
        PG8_STAGE(PG8_SB(0, 0), cB, voffB); PG8_STAGE(PG8_SB(0, 1), cB + hstep, voffB); PG8_STAGE(PG8_SA(0, 0), cA, voffA); PG8_STAGE(PG8_SA(0, 1), cA + hstep, voffA);
        if (wr == 1) PG8_BAR;
        PG8_WAIT_V(2); PG8_BAR;
        PG8_STAGE(PG8_SB(1, 0), cB + kstep, voffB); PG8_STAGE(PG8_SA(1, 0), cA + kstep, voffA); PG8_STAGE(PG8_SB(1, 1), cB + hstep + kstep, voffB);
        PG8_WAIT_V(6); PG8_BAR;
    } else {
        PG8_STAGE(PG8_SB(0, 0), cB, voffB); PG8_STAGE(PG8_SA(0, 0), cA, voffA); PG8_STAGE(PG8_SB(0, 1), cB + hstep, voffB); PG8_STAGE(PG8_SA(0, 1), cA + hstep, voffA);
        if (wr == 1) PG8_BAR;
        PG8_WAIT_V(4); PG8_BAR;
        PG8_STAGE(PG8_SB(1, 0), cB + kstep, voffB); PG8_STAGE(PG8_SA(1, 0), cA + kstep, voffA); PG8_STAGE(PG8_SB(1, 1), cB + hstep + kstep, voffB);
        PG8_WAIT_V(6); PG8_BAR;
    }
    for (;;) {
        const bool has_next = S.next(ui + 1, nxt);
        const char* nA = has_next ? (const char*)g.A + (size_t)nxt.pm * tstep : cA; const char* nB = has_next ? (const char*)g.Bt + (size_t)nxt.pn * tstep : cB;
        for (int t = 0; t < nt; t += 2) {
            const bool last = (t == nt - 2);
            const char* a1 = cA + (size_t)(t + 1) * kstep;
            const char* a2 = last ? nA : cA + (size_t)(t + 2) * kstep; const char* b2 = last ? nB : cB + (size_t)(t + 2) * kstep;
            const char* a3 = a2 + kstep; const char* b3 = b2 + kstep;
            if (last && has_next) S.a_ready(nxt);
            if constexpr (SP2) {
            PG8_LDB(B0, 0, 0); PG8_LDB(B1, 0, 1); PG8_SCHED; PG8_LDA(At, 0, 0); PG8_STAGE(PG8_SA(1, 1), a1 + hstep, voffA);
            PG8_WAIT_V(8); PG8_WAIT_L(0); PG8_BAR; PG8_MMA(0, 0, At, B0); PG8_MMA(0, 1, At, B1); PG8_BAR; PG8_SCHED;
            PG8_LDA(At, 0, 1); PG8_STAGE(PG8_SB(0, 0), b2, voffB); PG8_STAGE(PG8_SB(0, 1), b2 + hstep, voffB); PG8_STAGE(PG8_SA(0, 0), a2, voffA);
            PG8_WAIT_V(8); PG8_WAIT_L(0); PG8_BAR; PG8_MMA(1, 0, At, B0); PG8_MMA(1, 1, At, B1); PG8_BAR; PG8_SCHED;
            PG8_LDB(B0, 1, 0); PG8_LDB(B1, 1, 1); PG8_SCHED; PG8_LDA(At, 1, 0); PG8_STAGE(PG8_SA(0, 1), a2 + hstep, voffA);
            PG8_WAIT_V(8); PG8_WAIT_L(0); PG8_BAR; PG8_MMA(0, 0, At, B0); PG8_MMA(0, 1, At, B1); PG8_BAR; PG8_SCHED;
            PG8_LDA(At, 1, 1); PG8_STAGE(PG8_SB(1, 0), b3, voffB); PG8_STAGE(PG8_SB(1, 1), b3 + hstep, voffB); PG8_STAGE(PG8_SA(1, 0), a3, voffA);
            PG8_WAIT_V(8); PG8_WAIT_L(0); PG8_BAR; PG8_MMA(1, 0, At, B0); PG8_MMA(1, 1, At, B1); PG8_BAR; PG8_SCHED;
            } else {
            PG8_LDB(B0, 0, 0); PG8_SCHED; PG8_LDA(At, 0, 0); PG8_STAGE(PG8_SA(1, 1), a1 + hstep, voffA);
            PG8_WAIT_L(8); PG8_BAR; PG8_WAIT_L(0); PG8_MMA(0, 0, At, B0); PG8_BAR; PG8_SCHED;
            PG8_LDB(B1, 0, 1); PG8_STAGE(PG8_SB(0, 0), b2, voffB);
            PG8_BAR; PG8_WAIT_L(0); PG8_MMA(0, 1, At, B1); PG8_BAR;
            PG8_LDA(At, 0, 1); PG8_STAGE(PG8_SA(0, 0), a2, voffA);
            PG8_BAR; PG8_WAIT_L(0); PG8_MMA(1, 0, At, B0); PG8_BAR; PG8_SCHED;
            PG8_STAGE(PG8_SB(0, 1), b2 + hstep, voffB);
            PG8_WAIT_V(6); PG8_BAR; PG8_MMA(1, 1, At, B1); PG8_BAR;
            PG8_LDB(B0, 1, 0); PG8_SCHED; PG8_LDA(At, 1, 0); PG8_STAGE(PG8_SA(0, 1), a2 + hstep, voffA);
            PG8_WAIT_L(8); PG8_BAR; PG8_WAIT_L(0); PG8_MMA(0, 0, At, B0); PG8_BAR; PG8_SCHED;
            PG8_LDB(B1, 1, 1); PG8_STAGE(PG8_SB(1, 0), b3, voffB);
            PG8_BAR; PG8_WAIT_L(0); PG8_MMA(0, 1, At, B1); PG8_BAR;
            PG8_LDA(At, 1, 1); PG8_STAGE(PG8_SA(1, 0), a3, voffA);
            PG8_BAR; PG8_WAIT_L(0); PG8_MMA(1, 0, At, B0); PG8_BAR; PG8_SCHED;
            PG8_STAGE(PG8_SB(1, 1), b3 + hstep, voffB);
            PG8_WAIT_V(6); PG8_BAR; PG8_MMA(1, 1, At, B1); PG8_BAR;
            }
        }
        if constexpr (ALIGN_EPI) { if (wr == 0) PG8_BAR; }
        if constexpr (!Epi::AFTER_DRAIN) { E(acc, cur, wr, wc, fr, fq); S.done(cur); }
        if (!has_next) break;
#pragma unroll
        for (int a = 0; a < 2; ++a)
#pragma unroll
            for (int b = 0; b < 2; ++b)
#pragma unroll
                for (int m = 0; m < 4; ++m)
#pragma unroll
                    for (int n = 0; n < 2; ++n) acc[a][b][m][n] = (f32x4){0.f, 0.f, 0.f, 0.f};
        cur = nxt; cA = nA; cB = nB; ++ui;
        if constexpr (ALIGN_EPI) { if (wr == 1) PG8_BAR; }
    }
    PG8_WAIT_V(0);
    if constexpr (!ALIGN_EPI) { if (wr == 0) PG8_BAR; }
    PG8_BAR;
    if constexpr (Epi::AFTER_DRAIN) { E.fused(acc, cur, wr, wc, fr, fq, lds, wid, lane); S.done(cur); }
#undef PG8_SA
#undef PG8_SB
#undef PG8_STAGE
#undef PG8_LDA
#undef PG8_LDB
#undef PG8_MMA
#undef PG8_WAIT_V
#undef PG8_WAIT_L
#undef PG8_BAR
#undef PG8_SCHED
}
}
#define LAS __attribute__((address_space(3)))
typedef unsigned short bf16;
typedef float f32x4 __attribute__((ext_vector_type(4)));
typedef float f32x2 __attribute__((ext_vector_type(2)));
typedef float f32x16 __attribute__((ext_vector_type(16)));
typedef short bf16x8 __attribute__((ext_vector_type(8)));
typedef unsigned u32x4 __attribute__((ext_vector_type(4)));
typedef unsigned u32x2 __attribute__((ext_vector_type(2)));
constexpr int NB = 8, SEQ = 8192, DM = 1024, MT = NB * SEQ, FF = 2816, NMODC = 9216;
constexpr int RW_T = 128, RW_NC = SEQ / RW_T;
constexpr int LDS_BYTES = 147456;
constexpr size_t MiB = 1u << 20;
constexpr size_t WS_MOD = 0, WS_CTR = 1024 * 1024, WS_BAR = 1024 * 1024 + 65536;
constexpr size_t WS_WGU1 = 2 * MiB, WS_WD1 = 13 * MiB, WS_WIN = 19 * MiB, WS_WUQ = 24 * MiB, WS_WK = 25 * MiB, WS_WV = 25 * MiB + 512 * 1024, WS_WLORA = 26 * MiB, WS_WOUT = 27 * MiB, WS_WGU2 = 29 * MiB, WS_WD2 = 40 * MiB;
constexpr size_t WS_U = 50 * MiB;
constexpr size_t WS_ACT = 178 * MiB;
constexpr size_t WS_QN = 178 * MiB, WS_KVN = 226 * MiB, WS_LIN = 258 * MiB, WS_CS = 290 * MiB, WS_KR = 306 * MiB, WS_QB = 314 * MiB, WS_KN = 410 * MiB, WS_VT = 474 * MiB;
constexpr size_t WS_PRW = 538 * MiB, WS_PMLA = 762 * MiB, WS_DEC = 858 * MiB;
constexpr size_t WS_YB = 858 * MiB  , WS_CT = 986 * MiB;
constexpr size_t WS_G = 178 * MiB, WS_J = 242 * MiB, WS_SST = 314 * MiB, WS_AL = 762 * MiB;

__device__ __forceinline__ float bf2f(unsigned h) { return __uint_as_float(h << 16); }
__device__ __forceinline__ unsigned pk2(float a, float b) { typedef __bf16 bf2_t __attribute__((ext_vector_type(2))); f32x2 v = {a, b}; return __builtin_bit_cast(unsigned, __builtin_convertvector(v, bf2_t)); }
__device__ __forceinline__ float wave_sum(float v) {
#pragma unroll
    for (int o = 1; o < 64; o <<= 1) v += __shfl_xor(v, o);
    return v;
}
__device__ __forceinline__ void unpack8(const u32x4 w, float* f) { f[0] = bf2f(w.x & 0xffffu); f[1] = bf2f(w.x >> 16); f[2] = bf2f(w.y & 0xffffu); f[3] = bf2f(w.y >> 16); f[4] = bf2f(w.z & 0xffffu); f[5] = bf2f(w.z >> 16); f[6] = bf2f(w.w & 0xffffu); f[7] = bf2f(w.w >> 16); }

struct Args { const void* in[33]; float* out; unsigned char* ws; };

__device__ __forceinline__ const float* wsrc(const Args& a, int job, int p, int& ldw) {
    switch (job) {
    case 0: case 6: { const int pn = p >> 8, r = p & 255, bj = r >> 7, wc = (r >> 5) & 3, fq = (r >> 3) & 3, n = (r >> 2) & 1, e = r & 3; ldw = FF; const float* g = (const float*)a.in[job == 0 ? 6 : 29]; const float* u = (const float*)a.in[job == 0 ? 7 : 30]; return (n ? u : g) + 128 * pn + 32 * wc + 8 * fq + 4 * bj + e; }
    case 1: ldw = DM; return (const float*)a.in[8] + p;
    case 7: ldw = DM; return (const float*)a.in[31] + p;
    case 2: ldw = 2496; return p < 704 ? (const float*)a.in[10] + p : (p < 768 ? nullptr : (const float*)a.in[10] + (p - 64));
    case 3: { ldw = 768; const int h = p / 192, pp = p % 192; if (pp < 128) return (const float*)a.in[12] + h * 192 + pp; const int q = pp - 128, j = q >> 3, e = q & 7; const int dim = e < 4 ? 4 * j + e : 32 + 4 * j + (e - 4); return (const float*)a.in[12] + h * 192 + 128 + dim; }
    case 4: ldw = 1024; return (const float*)a.in[14] + (p >> 7) * 256 + (p & 127);
    case 5: ldw = 1024; return (const float*)a.in[14] + (p >> 7) * 256 + 128 + (p & 127);
    default: ldw = DM; return (const float*)a.in[27] + p;
    }
}
__device__ __forceinline__ void p0_transpose_item(const Args& a, int job, int K, int nblk, bf16* WT, LAS float* scr, int item, int lane) {
    const int kb = item / nblk, nb = item % nblk, k0 = 64 * kb, n0 = 32 * nb;
    int ldw; const float* src = wsrc(a, job, n0 + (lane & 31), ldw);
    float tv[32];
#pragma unroll
    for (int i = 0; i < 32; ++i) { const int kk = 2 * i + (lane >> 5); tv[i] = src ? src[(size_t)(k0 + kk) * ldw] : 0.f; }
#pragma unroll
    for (int i = 0; i < 32; ++i) { const int kk = 2 * i + (lane >> 5); scr[kk * 33 + (lane & 31)] = tv[i]; }
    asm volatile("s_waitcnt lgkmcnt(0)" ::: "memory");
    const int c = lane & 7;
#pragma unroll
    for (int j = 0; j < 4; ++j) { const int n = (lane >> 3) + 8 * j; const LAS float* s = scr + (8 * c) * 33 + n;
        u32x4 o; o.x = pk2(s[0 * 33], s[1 * 33]); o.y = pk2(s[2 * 33], s[3 * 33]); o.z = pk2(s[4 * 33], s[5 * 33]); o.w = pk2(s[6 * 33], s[7 * 33]);
        *(u32x4*)(WT + (size_t)(n0 + n) * K + k0 + 8 * c) = o; }
    asm volatile("s_waitcnt lgkmcnt(0)" ::: "memory");
}
__device__ __forceinline__ void phase_prologue(const Args& a, LAS unsigned char* lds, int tid, int lane, int wave) {
    unsigned char* ws = a.ws;
    __syncthreads();
    if (blockIdx.x < NMODC / 64) {
        LAS float* cact = (LAS float*)lds; LAS float* red = (LAS float*)(lds + 32768);
        const float* c = (const float*)a.in[1];
        for (int i = tid; i < NB * DM; i += 512) { const float v = c[i]; cact[i] = v / (1.f + __expf(-v)); }
        __syncthreads();
        const float* wm = (const float*)a.in[3]; const int col = blockIdx.x * 64 + lane; float acc[NB];
#pragma unroll
        for (int b = 0; b < NB; ++b) acc[b] = 0.f;
        for (int k0 = wave * 128; k0 < wave * 128 + 128; k0 += 16) { float wv[16];
#pragma unroll
            for (int i = 0; i < 16; ++i) wv[i] = wm[(size_t)(k0 + i) * NMODC + col];
#pragma unroll
            for (int i = 0; i < 16; ++i)
#pragma unroll
                for (int b = 0; b < NB; ++b) acc[b] += cact[b * DM + k0 + i] * wv[i]; }
#pragma unroll
        for (int b = 0; b < NB; ++b) red[(wave * NB + b) * 64 + lane] = acc[b];
        __syncthreads();
        { float s = ((const float*)a.in[4])[col];
#pragma unroll
          for (int w = 0; w < 8; ++w) s += red[(w * NB + wave) * 64 + lane];
          ((float*)(ws + WS_MOD))[(size_t)wave * NMODC + col] = s; }
        __syncthreads();
    }
    const int NMW = NMODC / 64;
    const bool split = (int)gridDim.x >= NMW + 96;
    const int gw = split ? ((int)blockIdx.x - NMW) * 8 + wave : (int)blockIdx.x * 8 + wave, NGW = split ? ((int)gridDim.x - NMW) * 8 : (int)gridDim.x * 8;
    LAS float* scr = (LAS float*)(lds + wave * 16384);
    const int jobK[9] = {DM, FF, DM, 384, 256, 256, DM, FF, DM};
    const int jobN[9] = {2 * FF, DM, 2560, 768, 512, 512, 2 * FF, DM, DM};
    const size_t jobO[9] = {WS_WGU1, WS_WD1, WS_WIN, WS_WUQ, WS_WK, WS_WV, WS_WGU2, WS_WD2, WS_WOUT};
#pragma unroll
    for (int j = 0; j < 9; ++j) { const int K = jobK[j], nblk = jobN[j] / 32, nit = (K / 64) * nblk;
        if (gw >= 0) for (int it = gw; it < nit; it += NGW) p0_transpose_item(a, j, K, nblk, (bf16*)(ws + jobO[j]), scr, it, lane); }
    { bf16* WL = (bf16*)(ws + WS_WLORA); const float* w2 = (const float*)a.in[18]; const float* a2 = (const float*)a.in[20]; const float* g2 = (const float*)a.in[21];
      if (gw >= 0) for (int i = gw * 64 + lane; i < 1536 * 256; i += NGW * 64) { const int c = i >> 8, k = i & 255; float v = 0.f;
          if (c < 512) { if (k < 64) v = w2[k * 512 + c]; } else if (c < 1024) { if (k >= 64 && k < 128) v = a2[(k - 64) * 512 + (c - 512)]; } else { if (k >= 128) v = g2[(k - 128) * 512 + (c - 1024)]; }
          WL[i] = (bf16)(pk2(v, 0.f) & 0xffffu); } }
}

__device__ __forceinline__ void phase_normmod(const float* X, const float* g, const float* mod, int sh_off, int sc_off, bf16* U, int lane, int gw, int NGW, int rowEnd = MT) {
#pragma unroll 1
    for (int row = gw; row < rowEnd; row += 2 * NGW) { const int row2 = row + NGW;
        const bool has2 = row2 < rowEnd; const int rB = has2 ? row2 : row;
        const f32x4* xa = (const f32x4*)(X + (size_t)row * DM) + lane; const f32x4* xb = (const f32x4*)(X + (size_t)rB * DM) + lane; f32x4 va[4], vb[4]; float sa = 0.f, sb = 0.f;
#pragma unroll
        for (int j = 0; j < 4; ++j) { va[j] = xa[64 * j]; vb[j] = xb[64 * j]; }
#pragma unroll
        for (int j = 0; j < 4; ++j) { sa += (va[j].x * va[j].x + va[j].y * va[j].y) + (va[j].z * va[j].z + va[j].w * va[j].w); sb += (vb[j].x * vb[j].x + vb[j].y * vb[j].y) + (vb[j].z * vb[j].z + vb[j].w * vb[j].w); }
#pragma unroll
        for (int o = 1; o < 64; o <<= 1) { sa += __shfl_xor(sa, o); sb += __shfl_xor(sb, o); }
        const float ra = rsqrtf(sa * (1.f / DM) + 1e-6f), rb = rsqrtf(sb * (1.f / DM) + 1e-6f);
        const float* ma = mod + (size_t)(row >> 13) * NMODC; const float* mb = mod + (size_t)(rB >> 13) * NMODC;
#pragma unroll
        for (int j = 0; j < 4; ++j) { const int col = 4 * lane + 256 * j; const f32x4 gv = *(const f32x4*)(g + col);
            { const f32x4 sc = *(const f32x4*)(ma + sc_off + col), sh = *(const f32x4*)(ma + sh_off + col); const f32x4 o = (va[j] * ra * gv) * (sc + 1.f) + sh; u32x2 w; w.x = pk2(o.x, o.y); w.y = pk2(o.z, o.w); *(u32x2*)(U + (size_t)row * DM + col) = w; }
            if (has2) { const f32x4 sc = *(const f32x4*)(mb + sc_off + col), sh = *(const f32x4*)(mb + sh_off + col); const f32x4 o = (vb[j] * rb * gv) * (sc + 1.f) + sh; u32x2 w; w.x = pk2(o.x, o.y); w.y = pk2(o.z, o.w); *(u32x2*)(U + (size_t)rB * DM + col) = w; } }
    }
}
__device__ __forceinline__ void phase_finalnorm(float* X, const float* g, int lane, int gw, int NGW, int rowEnd = MT) {
#pragma unroll 1
    for (int row = gw; row < rowEnd; row += 2 * NGW) { const int row2 = row + NGW; const bool has2 = row2 < rowEnd; const int rB = has2 ? row2 : row;
        f32x4* xa = (f32x4*)(X + (size_t)row * DM) + lane; f32x4* xb = (f32x4*)(X + (size_t)rB * DM) + lane; f32x4 va[4], vb[4]; float sa = 0.f, sb = 0.f;
#pragma unroll
        for (int j = 0; j < 4; ++j) { va[j] = xa[64 * j]; vb[j] = xb[64 * j]; }
#pragma unroll
        for (int j = 0; j < 4; ++j) { sa += (va[j].x * va[j].x + va[j].y * va[j].y) + (va[j].z * va[j].z + va[j].w * va[j].w); sb += (vb[j].x * vb[j].x + vb[j].y * vb[j].y) + (vb[j].z * vb[j].z + vb[j].w * vb[j].w); }
#pragma unroll
        for (int o = 1; o < 64; o <<= 1) { sa += __shfl_xor(sa, o); sb += __shfl_xor(sb, o); }
        const float ra = rsqrtf(sa * (1.f / DM) + 1e-6f), rb = rsqrtf(sb * (1.f / DM) + 1e-6f);
#pragma unroll
        for (int j = 0; j < 4; ++j) { const f32x4 gv = *(const f32x4*)(g + 4 * lane + 256 * j); xa[64 * j] = va[j] * ra * gv; if (has2) xb[64 * j] = vb[j] * rb * gv; }
    }
}
__device__ __forceinline__ void sincos_acc(float a, float& s, float& c) {
    const double ad = (double)a; const double k = rint(ad * 0.63661977236758134308); const float r = (float)(ad - k * 1.57079632679489661923); const float r2 = r * r;
    const float sp = r * (1.f + r2 * (-1.6666666667e-1f + r2 * (8.3333333333e-3f + r2 * (-1.9841269841e-4f + r2 * 2.7557319224e-6f))));
    const float cp = 1.f + r2 * (-0.5f + r2 * (4.1666666667e-2f + r2 * (-1.3888888889e-3f + r2 * (2.4801587302e-5f + r2 * (-2.7557319224e-7f)))));
    const int q = ((int)k) & 3;
    s = (q == 0) ? sp : ((q == 1) ? cp : ((q == 2) ? -sp : -cp));
    c = (q == 0) ? cp : ((q == 1) ? -sp : ((q == 2) ? -cp : sp));
}
struct MixIn { unsigned q[3], kvw[2]; unsigned short x1, x2; int pos; u32x4 kc, kp; u32x2 lc, lp; };
__device__ __forceinline__ void mixprep_load(MixIn& m, const bf16* PM, const bf16* PR, const int* pos, int row, int lane) {
    const bf16* pm = PM + (size_t)row * 768; const int ri = lane & 31;
#pragma unroll
    for (int j = 0; j < 3; ++j) m.q[j] = *(const unsigned*)(pm + 2 * lane + 128 * j);
#pragma unroll
    for (int j = 0; j < 2; ++j) m.kvw[j] = *(const unsigned*)(pm + 384 + 2 * lane + 128 * j);
    m.x1 = pm[640 + ri]; m.x2 = pm[672 + ri]; m.pos = pos[row];
    const bool hp = (row & (SEQ - 1)) != 0; const size_t rp = hp ? (size_t)(row - 1) : (size_t)row;
    m.kc = *(const u32x4*)(PR + (size_t)row * 1792 + 512 + 8 * lane); m.kp = *(const u32x4*)(PR + rp * 1792 + 512 + 8 * lane);
    m.lc = *(const u32x2*)(PR + (size_t)row * 1792 + 1536 + 4 * lane); m.lp = *(const u32x2*)(PR + rp * 1792 + 1536 + 4 * lane);
    if (!hp) { m.kp = (u32x4){0u, 0u, 0u, 0u}; m.lp = (u32x2){0u, 0u}; }
}
__device__ __forceinline__ void mixprep_compute(const MixIn& m, const Args& a, int row, int lane, float invf) {
    unsigned char* ws = a.ws;
    bf16* QN = (bf16*)(ws + WS_QN); bf16* KVN = (bf16*)(ws + WS_KVN); bf16* KR = (bf16*)(ws + WS_KR); bf16* LIN = (bf16*)(ws + WS_LIN); float* CS = (float*)(ws + WS_CS);
    const float* qg = (const float*)a.in[11]; const float* kvg = (const float*)a.in[13]; const float* mix = (const float*)a.in[16] + 1536; const int ri = lane & 31;
    float q[6], kq[4]; float s = 0.f, s2 = 0.f;
#pragma unroll
    for (int j = 0; j < 3; ++j) { q[2 * j] = bf2f(m.q[j] & 0xffffu); q[2 * j + 1] = bf2f(m.q[j] >> 16); s += q[2 * j] * q[2 * j] + q[2 * j + 1] * q[2 * j + 1]; }
#pragma unroll
    for (int j = 0; j < 2; ++j) { kq[2 * j] = bf2f(m.kvw[j] & 0xffffu); kq[2 * j + 1] = bf2f(m.kvw[j] >> 16); s2 += kq[2 * j] * kq[2 * j] + kq[2 * j + 1] * kq[2 * j + 1]; }
    float kc[8], kp[8]; unpack8(m.kc, kc); unpack8(m.kp, kp);
    const float* mk = (const float*)a.in[16] + 512 + 8 * lane; const float* kkp = (const float*)a.in[22] + 8 * lane; float ss = 0.f;
#pragma unroll
    for (int e = 0; e < 8; ++e) { const float kx = (kc[e] + (kp[e] - kc[e]) * mk[e]) * kkp[e]; ss += kx * kx; }
#pragma unroll
    for (int o = 1; o < 64; o <<= 1) { s += __shfl_xor(s, o); s2 += __shfl_xor(s2, o); if (o < 8) ss += __shfl_xor(ss, o); }
    const float rinv = rsqrtf(s * (1.f / 384.f) + 1e-6f), rinv2 = rsqrtf(s2 * (1.f / 256.f) + 1e-6f);
#pragma unroll
    for (int j = 0; j < 3; ++j) { const int col = 2 * lane + 128 * j; *(unsigned*)(QN + (size_t)row * 384 + col) = pk2(q[2 * j] * rinv * qg[col], q[2 * j + 1] * rinv * qg[col + 1]); }
#pragma unroll
    for (int j = 0; j < 2; ++j) { const int col = 2 * lane + 128 * j; *(unsigned*)(KVN + (size_t)row * 256 + col) = pk2(kq[2 * j] * rinv2 * kvg[col], kq[2 * j + 1] * rinv2 * kvg[col + 1]); }
    if ((lane & 7) == 0) ((float*)(ws + WS_CT))[(size_t)row * 8 + (lane >> 3)] = 1.f / fmaxf(sqrtf(ss), 1e-12f);
    { const float ang = (float)m.pos * invf; float sn, cn; sincos_acc(ang, sn, cn);
      const float x1 = bf2f(m.x1), x2 = bf2f(m.x2);
      if (lane < 32) { CS[(size_t)row * 64 + ri] = cn; CS[(size_t)row * 64 + 32 + ri] = sn;
          const unsigned o = pk2(x1 * cn - x2 * sn, x2 * cn + x1 * sn);
          KR[(size_t)row * 64 + 8 * (ri >> 2) + (ri & 3)] = (bf16)(o & 0xffffu); KR[(size_t)row * 64 + 8 * (ri >> 2) + 4 + (ri & 3)] = (bf16)(o >> 16); } }
    { const f32x4 mx = *(const f32x4*)(mix + 4 * lane);
      float cu[4] = {bf2f(m.lc.x & 0xffffu), bf2f(m.lc.x >> 16), bf2f(m.lc.y & 0xffffu), bf2f(m.lc.y >> 16)}; const float pv[4] = {bf2f(m.lp.x & 0xffffu), bf2f(m.lp.x >> 16), bf2f(m.lp.y & 0xffffu), bf2f(m.lp.y >> 16)};
#pragma unroll
      for (int e = 0; e < 4; ++e) { float p = cu[e] + (pv[e] - cu[e]) * mx[e];
          if (lane < 16) p = 1.f - 2.f / (1.f + __expf(2.f * p)); else if (lane >= 32) p = 1.f / (1.f + __expf(-p));
          cu[e] = p; }
      u32x2 w; w.x = pk2(cu[0], cu[1]); w.y = pk2(cu[2], cu[3]); *(u32x2*)(LIN + (size_t)row * 256 + 4 * lane) = w; }
}
__device__ __forceinline__ void phase_mixprep(const Args& a, int lane, int gw, int NGW, int rowEnd = MT) {
    unsigned char* ws = a.ws;
    const bf16* PM = (const bf16*)(ws + WS_PMLA); const bf16* PR = (const bf16*)(ws + WS_PRW); const int* pos = (const int*)a.in[2];
    const float invf = powf(10000.0f, -(float)(lane & 31) / 32.0f);
#pragma unroll 1
    for (int row = gw; row < rowEnd; row += 2 * NGW) { const int row2 = row + NGW; const bool has2 = row2 < rowEnd;
        MixIn A, B; mixprep_load(A, PM, PR, pos, row, lane); mixprep_load(B, PM, PR, pos, has2 ? row2 : row, lane);
        mixprep_compute(A, a, row, lane, invf); if (has2) mixprep_compute(B, a, row2, lane, invf); }
}
__device__ __forceinline__ void phase_yanorm(bf16* YC, const float* g, int lane, int gw, int NGW) {
    for (int row = gw; row < MT; row += NGW) { u32x4* p = (u32x4*)(YC + (size_t)row * DM + 8 * lane); float f[8]; unpack8(*p, f); float s = 0.f;
#pragma unroll
        for (int e = 0; e < 8; ++e) s += f[e] * f[e];
        const float rinv = rsqrtf(wave_sum(s) * (1.f / 512.f) + 1e-6f); const f32x4 g0 = *(const f32x4*)(g + 8 * lane), g1 = *(const f32x4*)(g + 8 * lane + 4);
        u32x4 o; o.x = pk2(f[0] * rinv * g0.x, f[1] * rinv * g0.y); o.y = pk2(f[2] * rinv * g0.z, f[3] * rinv * g0.w); o.z = pk2(f[4] * rinv * g1.x, f[5] * rinv * g1.y); o.w = pk2(f[6] * rinv * g1.z, f[7] * rinv * g1.w); *p = o; }
}

constexpr int AT_KSTR = 400, AT_VSTR = 144, AT_KB = 64 * AT_KSTR, AT_VB = 128 * AT_VSTR, AT_STAGE = AT_KB + AT_VB;
__device__ __forceinline__ void attn_unit(const bf16* QB, const bf16* KN, const bf16* KR, const bf16* VT, bf16* YC, LAS unsigned char* lds, int b, int h, int u, int tid, int lane, int wave) {
    const int r32 = lane & 31, hi = lane >> 5;
    const int q0 = u * 256 + wave * 32; const size_t tokq = (size_t)b * SEQ + q0 + r32;
    const int nt_unit = 4 * u + 4, nt_wave = 4 * u + (wave >> 1) + 1;
    bf16x8 qf[12];
#pragma unroll
    for (int ks = 0; ks < 12; ++ks) qf[ks] = *(const bf16x8*)(QB + tokq * 768 + h * 192 + 16 * ks + 8 * hi);
    f32x16 ot[4];
#pragma unroll
    for (int d = 0; d < 4; ++d)
#pragma unroll
        for (int i = 0; i < 16; ++i) ot[d][i] = 0.f;
    float m_run = -INFINITY, l_run = 0.f;
    unsigned knoff[2], vtoff[2]; int kndst[2], vtdst[2];
#pragma unroll
    for (int i = 0; i < 2; ++i) { const int c = tid + 512 * i; { const int row = c >> 4, cc = c & 15; knoff[i] = (unsigned)((b * SEQ + row) * 512 + h * 128 + cc * 8); kndst[i] = row * AT_KSTR + cc * 16; }
        { const int row = c >> 3, cc = c & 7; vtoff[i] = (unsigned)((h * 128 + row) * MT + b * SEQ + cc * 8); vtdst[i] = AT_KB + row * AT_VSTR + cc * 16; } }
    const unsigned kroff = (unsigned)((b * SEQ + (tid >> 3)) * 64 + (tid & 7) * 8); const int krdst = (tid >> 3) * AT_KSTR + 256 + (tid & 7) * 16;
    u32x4 kreg[3], vreg[2];
#pragma unroll
    for (int i = 0; i < 2; ++i) { kreg[i] = *(const u32x4*)(KN + knoff[i]); vreg[i] = *(const u32x4*)(VT + vtoff[i]); }
    kreg[2] = *(const u32x4*)(KR + kroff);
    __syncthreads();
#pragma unroll
    for (int i = 0; i < 2; ++i) { *(LAS u32x4*)(lds + kndst[i]) = kreg[i]; *(LAS u32x4*)(lds + vtdst[i]) = vreg[i]; }
    *(LAS u32x4*)(lds + krdst) = kreg[2];
    if (nt_unit > 1) {
#pragma unroll
        for (int i = 0; i < 2; ++i) { kreg[i] = *(const u32x4*)(KN + (knoff[i] + 64u * 512u)); vreg[i] = *(const u32x4*)(VT + (vtoff[i] + 64u)); }
        kreg[2] = *(const u32x4*)(KR + (kroff + 64u * 64u)); }
    __syncthreads();
    for (int kt = 0; kt < nt_unit; ++kt) {
        if (kt + 1 < nt_unit) { LAS unsigned char* nx = lds + ((kt + 1) & 1) * AT_STAGE;
#pragma unroll
            for (int i = 0; i < 2; ++i) { *(LAS u32x4*)(nx + kndst[i]) = kreg[i]; *(LAS u32x4*)(nx + vtdst[i]) = vreg[i]; }
            *(LAS u32x4*)(nx + krdst) = kreg[2];
            if (kt + 2 < nt_unit) { const unsigned t2 = (unsigned)(kt + 2) * 64u;
#pragma unroll
                for (int i = 0; i < 2; ++i) { kreg[i] = *(const u32x4*)(KN + (knoff[i] + t2 * 512u)); vreg[i] = *(const u32x4*)(VT + (vtoff[i] + t2)); }
                kreg[2] = *(const u32x4*)(KR + (kroff + t2 * 64u)); }
        }
        LAS unsigned char* st = lds + (kt & 1) * AT_STAGE;
        if (kt < nt_wave) {
            f32x16 sa[2];
#pragma unroll
            for (int mt = 0; mt < 2; ++mt) {
#pragma unroll
                for (int i = 0; i < 16; ++i) sa[mt][i] = 0.f;
#pragma unroll
                for (int ks = 0; ks < 12; ++ks) { const bf16x8 af = *(const LAS bf16x8*)(st + (32 * mt + r32) * AT_KSTR + 32 * ks + 16 * hi);
                    sa[mt] = __builtin_amdgcn_mfma_f32_32x32x16_bf16(af, qf[ks], sa[mt], 0, 0, 0); }
            }
            float mx = sa[0][0];
#pragma unroll
            for (int i = 1; i < 16; ++i) mx = fmaxf(mx, sa[0][i]);
#pragma unroll
            for (int i = 0; i < 16; ++i) mx = fmaxf(mx, sa[1][i]);
            mx = fmaxf(mx, __shfl_xor(mx, 32));
            const bool grow = __builtin_amdgcn_ballot_w64(mx - m_run > 8.0f) != 0ull;
            const float m_new = grow ? fmaxf(m_run, mx) : m_run; const float alpha = grow ? __builtin_amdgcn_exp2f(m_run - m_new) : 1.0f; m_run = m_new;
            float ls = 0.f;
#pragma unroll
            for (int mt = 0; mt < 2; ++mt)
#pragma unroll
                for (int i = 0; i < 16; ++i) { const float p = __builtin_amdgcn_exp2f(sa[mt][i] - m_new); sa[mt][i] = p; ls += p; }
            l_run = l_run * alpha + ls;
            if (grow) {
#pragma unroll
                for (int d = 0; d < 4; ++d)
#pragma unroll
                    for (int i = 0; i < 16; ++i) ot[d][i] *= alpha;
            }
#pragma unroll
            for (int mt = 0; mt < 2; ++mt)
#pragma unroll
                for (int s = 0; s < 2; ++s) { u32x4 w; w.x = pk2(sa[mt][8 * s + 0], sa[mt][8 * s + 1]); w.y = pk2(sa[mt][8 * s + 2], sa[mt][8 * s + 3]); w.z = pk2(sa[mt][8 * s + 4], sa[mt][8 * s + 5]); w.w = pk2(sa[mt][8 * s + 6], sa[mt][8 * s + 7]);
                    const bf16x8 pf = __builtin_bit_cast(bf16x8, w);
#pragma unroll
                    for (int d = 0; d < 4; ++d) { const bf16x8 vf = *(const LAS bf16x8*)(st + AT_KB + (32 * d + r32) * AT_VSTR + 64 * mt + 32 * s + 16 * hi);
                        ot[d] = __builtin_amdgcn_mfma_f32_32x32x16_bf16(vf, pf, ot[d], 0, 0, 0); } }
        }
        __syncthreads();
    }
    const float linv = 1.f / (l_run + __shfl_xor(l_run, 32));
    bf16* orow = YC + tokq * DM + h * 128;
#pragma unroll
    for (int d = 0; d < 4; ++d)
#pragma unroll
        for (int g = 0; g < 4; ++g) { u32x2 w; w.x = pk2(ot[d][4 * g] * linv, ot[d][4 * g + 1] * linv); w.y = pk2(ot[d][4 * g + 2] * linv, ot[d][4 * g + 3] * linv); *(u32x2*)(orow + 32 * d + 8 * g + 4 * hi) = w; }
}
constexpr int RW_BLK = 8, RW_VEC = 6 * 64, RW_LDS_WAVE = RW_BLK * RW_VEC * 4;
__device__ __forceinline__ void rw_shift8(const bf16* PR, const float* mix, size_t tok, int s, int col, float* cur) {
    float prv[8]; unpack8(*(const u32x4*)(PR + tok * 1792 + col), cur);
    u32x4 pw = {0u, 0u, 0u, 0u}; if (s > 0) pw = *(const u32x4*)(PR + (tok - 1) * 1792 + col); unpack8(pw, prv);
    const f32x4 m0 = *(const f32x4*)(mix + col), m1 = *(const f32x4*)(mix + col + 4);
#pragma unroll
    for (int e = 0; e < 4; ++e) { cur[e] += (prv[e] - cur[e]) * m0[e]; cur[e + 4] += (prv[e + 4] - cur[e + 4]) * m1[e]; }
}
__device__ __forceinline__ void rw_prep(const Args& a, LAS float* blk, int b, int h, int s0, int lane) {
    unsigned char* ws = a.ws;
    const bf16* PR = (const bf16*)(ws + WS_PRW); const float* DEC = (const float*)(ws + WS_DEC); const bf16* AL = (const bf16*)(ws + WS_AL);
    const float* mix = (const float*)a.in[16]; const float* k_k = (const float*)a.in[22]; const float* k_a = (const float*)a.in[23];
    const int tt = lane >> 3, k0 = 8 * (lane & 7), ch = h * 64 + k0; const int s = s0 + tt; const size_t tok = (size_t)b * SEQ + s;
    LAS float* o = blk + tt * RW_VEC + k0;
    { float r[8]; rw_shift8(PR, mix, tok, s, ch, r); *(LAS f32x4*)(o + 256) = (f32x4){r[0], r[1], r[2], r[3]}; *(LAS f32x4*)(o + 260) = (f32x4){r[4], r[5], r[6], r[7]}; }
    __builtin_amdgcn_sched_barrier(0);
    { float r[8]; rw_shift8(PR, mix, tok, s, 1024 + ch, r); *(LAS f32x4*)(o + 320) = (f32x4){r[0], r[1], r[2], r[3]}; *(LAS f32x4*)(o + 324) = (f32x4){r[4], r[5], r[6], r[7]}; }
    __builtin_amdgcn_sched_barrier(0);
    { const f32x4 d0 = *(const f32x4*)(DEC + tok * 512 + ch), d1 = *(const f32x4*)(DEC + tok * 512 + ch + 4); *(LAS f32x4*)(o) = d0; *(LAS f32x4*)(o + 4) = d1; }
    __builtin_amdgcn_sched_barrier(0);
    float kc[8]; rw_shift8(PR, mix, tok, s, 512 + ch, kc);
    float al[8]; unpack8(*(const u32x4*)(AL + tok * 512 + ch), al);
    const f32x4 kk0 = *(const f32x4*)(k_k + ch), kk1 = *(const f32x4*)(k_k + ch + 4), ka0 = *(const f32x4*)(k_a + ch), ka1 = *(const f32x4*)(k_a + ch + 4);
    float kk[8], ss = 0.f;
#pragma unroll
    for (int e = 0; e < 8; ++e) { kk[e] = kc[e] * (e < 4 ? kk0[e & 3] : kk1[e & 3]); ss += kk[e] * kk[e]; }
    ss += __shfl_xor(ss, 1); ss += __shfl_xor(ss, 2); ss += __shfl_xor(ss, 4);
    const float rn = 1.f / fmaxf(sqrtf(ss), 1e-12f);
    f32x4 t0, t1;
#pragma unroll
    for (int e = 0; e < 4; ++e) { t0[e] = kk[e] * rn; t1[e] = kk[e + 4] * rn; }
    *(LAS f32x4*)(o + 64) = t0; *(LAS f32x4*)(o + 68) = t1;
#pragma unroll
    for (int e = 0; e < 4; ++e) { t0[e] *= al[e]; t1[e] *= al[e + 4]; }
    *(LAS f32x4*)(o + 128) = t0; *(LAS f32x4*)(o + 132) = t1;
#pragma unroll
    for (int e = 0; e < 4; ++e) { t0[e] = kc[e] * (1.f + (al[e] - 1.f) * ka0[e]); t1[e] = kc[e + 4] * (1.f + (al[e + 4] - 1.f) * ka1[e]); }
    *(LAS f32x4*)(o + 192) = t0; *(LAS f32x4*)(o + 196) = t1;
}
#define RW_LDS_FENCE() do { asm volatile("s_waitcnt lgkmcnt(0)" ::: "memory"); __builtin_amdgcn_wave_barrier(); } while (0)
template <bool IDENT>
__device__ __forceinline__ void rw_pass1(const Args& a, LAS float* blk, int item, int lane) {
    const int bh = item / RW_NC, c = item % RW_NC, b = bh >> 3, h = bh & 7;
    float sV[64];
#pragma unroll
    for (int k = 0; k < 64; ++k) sV[k] = (IDENT && k == lane) ? 1.f : 0.f;
    for (int blkI = 0; blkI < RW_T / RW_BLK; ++blkI) {
        RW_LDS_FENCE();
        rw_prep(a, blk, b, h, c * RW_T + blkI * RW_BLK, lane);
        RW_LDS_FENCE();
#pragma unroll 1
        for (int tt = 0; tt < RW_BLK; ++tt) { const LAS float* vb = blk + tt * RW_VEC;
            float dV = 0.f;
#pragma unroll
            for (int k4 = 0; k4 < 16; ++k4) { const f32x4 kk = *(const LAS f32x4*)(vb + 64 + 4 * k4);
#pragma unroll
                for (int e = 0; e < 4; ++e) dV += sV[4 * k4 + e] * kk[e]; }
            const float vv = IDENT ? 0.f : vb[320 + lane];
#pragma unroll
            for (int k4 = 0; k4 < 16; ++k4) { const f32x4 w = *(const LAS f32x4*)(vb + 4 * k4), bb = *(const LAS f32x4*)(vb + 128 + 4 * k4);
                if (IDENT) {
#pragma unroll
                    for (int e = 0; e < 4; ++e) sV[4 * k4 + e] = sV[4 * k4 + e] * w[e] - dV * bb[e];
                } else { const f32x4 kv = *(const LAS f32x4*)(vb + 192 + 4 * k4);
#pragma unroll
                    for (int e = 0; e < 4; ++e) sV[4 * k4 + e] = sV[4 * k4 + e] * w[e] + (vv * kv[e] - dV * bb[e]); } }
        }
    }
    float* O = (float*)(a.ws + (IDENT ? WS_G : WS_J)) + ((size_t)item * 64 + lane) * 64;
#pragma unroll
    for (int k4 = 0; k4 < 16; ++k4) *(f32x4*)(O + 4 * k4) = (f32x4){sV[4 * k4], sV[4 * k4 + 1], sV[4 * k4 + 2], sV[4 * k4 + 3]};
}
__device__ __forceinline__ void rw_pass3(const Args& a, LAS float* blk, int item, int lane) {
    const int bh = item / RW_NC, c = item % RW_NC, b = bh >> 3, h = bh & 7, ch = h * 64 + lane;
    float sV[64];
    { const float* S0 = (const float*)(a.ws + WS_SST) + ((size_t)item * 64 + lane) * 64;
#pragma unroll
      for (int k4 = 0; k4 < 16; ++k4) { const f32x4 t = *(const f32x4*)(S0 + 4 * k4); sV[4 * k4] = t.x; sV[4 * k4 + 1] = t.y; sV[4 * k4 + 2] = t.z; sV[4 * k4 + 3] = t.w; } }
    const float rk = ((const float*)a.in[24])[ch], lnw = ((const float*)a.in[25])[ch], lnb = ((const float*)a.in[26])[ch];
    bf16* YC = (bf16*)(a.ws + WS_U);
    for (int blkI = 0; blkI < RW_T / RW_BLK; ++blkI) {
        RW_LDS_FENCE();
        rw_prep(a, blk, b, h, c * RW_T + blkI * RW_BLK, lane);
        RW_LDS_FENCE();
#pragma unroll 1
        for (int tt = 0; tt < RW_BLK; ++tt) { const LAS float* vb = blk + tt * RW_VEC;
            float dV = 0.f;
#pragma unroll
            for (int k4 = 0; k4 < 16; ++k4) { const f32x4 kk = *(const LAS f32x4*)(vb + 64 + 4 * k4);
#pragma unroll
                for (int e = 0; e < 4; ++e) dV += sV[4 * k4 + e] * kk[e]; }
            const float vv = vb[320 + lane]; float y = 0.f;
#pragma unroll
            for (int k4 = 0; k4 < 16; ++k4) { const f32x4 w = *(const LAS f32x4*)(vb + 4 * k4), bb = *(const LAS f32x4*)(vb + 128 + 4 * k4), kv = *(const LAS f32x4*)(vb + 192 + 4 * k4), r = *(const LAS f32x4*)(vb + 256 + 4 * k4);
#pragma unroll
                for (int e = 0; e < 4; ++e) { const float sn = sV[4 * k4 + e] * w[e] + (vv * kv[e] - dV * bb[e]); sV[4 * k4 + e] = sn; y += sn * r[e]; } }
            float s1 = y, s2 = y * y, s3 = vb[256 + lane] * vb[192 + lane] * rk;
#pragma unroll
            for (int o = 1; o < 64; o <<= 1) { s1 += __shfl_xor(s1, o); s2 += __shfl_xor(s2, o); s3 += __shfl_xor(s3, o); }
            const float mean = s1 * (1.f / 64.f), var = fmaxf(s2 * (1.f / 64.f) - mean * mean, 0.f);
            const float yn = (y - mean) * rsqrtf(var + 64e-5f) * lnw + lnb;
            bf16* gp = YC + ((size_t)b * SEQ + c * RW_T + blkI * RW_BLK + tt) * DM + 512 + ch;
            const float g = bf2f(*gp);
            *gp = (bf16)(pk2((yn + s3 * vv) * g, 0.f) & 0xffffu);
        }
    }
}
__device__ __forceinline__ void rw_scan(const Args& a, LAS unsigned char* lds, int bh, int tid) {
    LAS float* Sb = (LAS float*)lds; LAS float* Gb = (LAS float*)(lds + 64 * 68 * 4);
    const int v = tid >> 3, k0 = 8 * (tid & 7);
    const float* G = (const float*)(a.ws + WS_G) + (size_t)bh * RW_NC * 4096; const float* J = (const float*)(a.ws + WS_J) + (size_t)bh * RW_NC * 4096; float* SST = (float*)(a.ws + WS_SST) + (size_t)bh * RW_NC * 4096;
    f32x4 s0 = {0.f, 0.f, 0.f, 0.f}, s1 = s0;
    f32x4 g0 = *(const f32x4*)(G + tid * 8), g1 = *(const f32x4*)(G + tid * 8 + 4), j0 = *(const f32x4*)(J + v * 64 + k0), j1 = *(const f32x4*)(J + v * 64 + k0 + 4);
    for (int c = 0; c < RW_NC; ++c) {
        *(f32x4*)(SST + (size_t)c * 4096 + v * 64 + k0) = s0; *(f32x4*)(SST + (size_t)c * 4096 + v * 64 + k0 + 4) = s1;
        if (c == RW_NC - 1) break;
        *(LAS f32x4*)(Sb + v * 68 + k0) = s0; *(LAS f32x4*)(Sb + v * 68 + k0 + 4) = s1;
        *(LAS f32x4*)(Gb + tid * 8) = g0; *(LAS f32x4*)(Gb + tid * 8 + 4) = g1;
        f32x4 a0 = j0, a1 = j1;
        __syncthreads();
        if (c + 1 < RW_NC - 1) { const size_t o = (size_t)(c + 1) * 4096; g0 = *(const f32x4*)(G + o + tid * 8); g1 = *(const f32x4*)(G + o + tid * 8 + 4); j0 = *(const f32x4*)(J + o + v * 64 + k0); j1 = *(const f32x4*)(J + o + v * 64 + k0 + 4); }
#pragma unroll 4
        for (int i4 = 0; i4 < 16; ++i4) { const f32x4 sv = *(const LAS f32x4*)(Sb + v * 68 + 4 * i4);
#pragma unroll
            for (int e = 0; e < 4; ++e) { const f32x4 ga = *(const LAS f32x4*)(Gb + (4 * i4 + e) * 64 + k0), gb = *(const LAS f32x4*)(Gb + (4 * i4 + e) * 64 + k0 + 4); a0 += ga * sv[e]; a1 += gb * sv[e]; } }
        s0 = a0; s1 = a1;
        __syncthreads();
    }
}

constexpr int SQ_BLK = 16, SQ_VEC = 392, SQ_BUF = SQ_BLK * SQ_VEC * 4, SQ_YOFF = 2 * SQ_BUF, SQ_YBUF = SQ_BLK * 64 * 8, SQ_NBLK = SEQ / SQ_BLK;
__device__ __forceinline__ float dpp_f(float v, const int ctrl) { return v; }
#define DPPF(v, ctrl) __builtin_bit_cast(float, __builtin_amdgcn_update_dpp(0, __builtin_bit_cast(int, (v)), (ctrl), 0xF, 0xF, true))
__device__ __forceinline__ float red8(float v) { v += DPPF(v, 0xB1); v += DPPF(v, 0x4E); v += DPPF(v, 0x141); return v; }
__device__ __forceinline__ void rw_seq(const Args& a, LAS unsigned char* lds, int bh, int tid, bool do_store) {
    const int b = bh >> 3, h = bh & 7, wave = __builtin_amdgcn_readfirstlane(tid >> 6), lane = tid & 63;
    unsigned char* ws = a.ws;
    if (wave >= 4) {
        const int tp = tid - 256, tt = tp >> 4, kq = tp & 15, k0 = 4 * kq, ch = h * 64 + k0;
        const bf16* PR = (const bf16*)(ws + WS_PRW); const float* DEC = (const float*)(ws + WS_DEC); const bf16* AL = (const bf16*)(ws + WS_AL); bf16* YC = (bf16*)(ws + WS_U);
        const float* mixp = (const float*)a.in[16];
        const f32x4 mx0 = *(const f32x4*)(mixp + ch), mx1 = *(const f32x4*)(mixp + 512 + ch), mx2 = *(const f32x4*)(mixp + 1024 + ch);
        const f32x4 kkc = *(const f32x4*)((const float*)a.in[22] + ch), kac = *(const f32x4*)((const float*)a.in[23] + ch), rkc = *(const f32x4*)((const float*)a.in[24] + ch);
        const f32x4 lnw = *(const f32x4*)((const float*)a.in[25] + ch), lnb = *(const f32x4*)((const float*)a.in[26] + ch);
        u32x2 cur[3], prv[3], alr; f32x4 dcr; u32x2 cur2[3], prv2[3], alr2; f32x4 dcr2; u32x2 gq = {0u, 0u};
        { const size_t tok = (size_t)b * SEQ + tt;
#pragma unroll
          for (int j = 0; j < 3; ++j) { cur[j] = *(const u32x2*)(PR + tok * 1792 + 512 * j + ch); prv[j] = (u32x2){0u, 0u}; if (tt > 0) prv[j] = *(const u32x2*)(PR + (tok - 1) * 1792 + 512 * j + ch); }
          alr = *(const u32x2*)(AL + tok * 512 + ch); dcr = *(const f32x4*)(DEC + tok * 512 + ch); }
        { const size_t tok = (size_t)b * SEQ + SQ_BLK + tt;
#pragma unroll
          for (int j = 0; j < 3; ++j) { cur2[j] = *(const u32x2*)(PR + tok * 1792 + 512 * j + ch); prv2[j] = *(const u32x2*)(PR + (tok - 1) * 1792 + 512 * j + ch); }
          alr2 = *(const u32x2*)(AL + tok * 512 + ch); dcr2 = *(const f32x4*)(DEC + tok * 512 + ch); }
        for (int n = 0; n <= SQ_NBLK + 1; ++n) {
            if (n < SQ_NBLK) {
                LAS float* o = (LAS float*)(lds + (n & 1) * SQ_BUF) + tt * SQ_VEC + k0;
                f32x4 r4, k4, v4, al4;
                { const f32x4 c0 = {bf2f(cur[0].x & 0xffffu), bf2f(cur[0].x >> 16), bf2f(cur[0].y & 0xffffu), bf2f(cur[0].y >> 16)}, p0 = {bf2f(prv[0].x & 0xffffu), bf2f(prv[0].x >> 16), bf2f(prv[0].y & 0xffffu), bf2f(prv[0].y >> 16)}; r4 = c0 + (p0 - c0) * mx0; }
                { const f32x4 c0 = {bf2f(cur[1].x & 0xffffu), bf2f(cur[1].x >> 16), bf2f(cur[1].y & 0xffffu), bf2f(cur[1].y >> 16)}, p0 = {bf2f(prv[1].x & 0xffffu), bf2f(prv[1].x >> 16), bf2f(prv[1].y & 0xffffu), bf2f(prv[1].y >> 16)}; k4 = c0 + (p0 - c0) * mx1; }
                { const f32x4 c0 = {bf2f(cur[2].x & 0xffffu), bf2f(cur[2].x >> 16), bf2f(cur[2].y & 0xffffu), bf2f(cur[2].y >> 16)}, p0 = {bf2f(prv[2].x & 0xffffu), bf2f(prv[2].x >> 16), bf2f(prv[2].y & 0xffffu), bf2f(prv[2].y >> 16)}; v4 = c0 + (p0 - c0) * mx2; }
                al4 = (f32x4){bf2f(alr.x & 0xffffu), bf2f(alr.x >> 16), bf2f(alr.y & 0xffffu), bf2f(alr.y >> 16)};
                f32x4 kk = k4 * kkc; float ss = (kk.x * kk.x + kk.y * kk.y) + (kk.z * kk.z + kk.w * kk.w);
                ss += __shfl_xor(ss, 1); ss += __shfl_xor(ss, 2); ss += __shfl_xor(ss, 4); ss += __shfl_xor(ss, 8);
                const float rn = 1.f / fmaxf(sqrtf(ss), 1e-12f); kk = kk * rn;
                const f32x4 kv = k4 * ((al4 - 1.f) * kac + 1.f);
                const f32x4 cp = r4 * kv * rkc; float cs = (cp.x + cp.y) + (cp.z + cp.w);
                cs += __shfl_xor(cs, 1); cs += __shfl_xor(cs, 2); cs += __shfl_xor(cs, 4); cs += __shfl_xor(cs, 8);
                *(LAS f32x4*)(o) = dcr; *(LAS f32x4*)(o + 64) = kk; *(LAS f32x4*)(o + 128) = kk * al4; *(LAS f32x4*)(o + 192) = kv; *(LAS f32x4*)(o + 256) = r4; *(LAS f32x4*)(o + 320) = v4;
                if (kq == 0) o[384] = cs;
            }
#pragma unroll
            for (int j = 0; j < 3; ++j) { cur[j] = cur2[j]; prv[j] = prv2[j]; }
            alr = alr2; dcr = dcr2;
            if (n + 2 < SQ_NBLK) { const size_t tok = (size_t)b * SEQ + (n + 2) * SQ_BLK + tt;
#pragma unroll
                for (int j = 0; j < 3; ++j) { cur2[j] = *(const u32x2*)(PR + tok * 1792 + 512 * j + ch); prv2[j] = *(const u32x2*)(PR + (tok - 1) * 1792 + 512 * j + ch); }
                alr2 = *(const u32x2*)(AL + tok * 512 + ch); dcr2 = *(const f32x4*)(DEC + tok * 512 + ch); }
            if (n >= 2) {
                const LAS f32x4* yb = (const LAS f32x4*)(lds + SQ_YOFF + (n & 1) * SQ_YBUF) + (tt * 64 + k0) / 2;
                const f32x4 y01 = yb[0], y23 = yb[1];
                float s1 = (y01.x + y01.z) + (y23.x + y23.z), s2 = (y01.x * y01.x + y01.z * y01.z) + (y23.x * y23.x + y23.z * y23.z);
#pragma unroll
                for (int o = 1; o < 16; o <<= 1) { s1 += __shfl_xor(s1, o); s2 += __shfl_xor(s2, o); }
                const float mean = s1 * (1.f / 64.f), var = fmaxf(s2 * (1.f / 64.f) - mean * mean, 0.f), rstd = rsqrtf(var + 64e-5f);
                bf16* gp = YC + ((size_t)b * SEQ + (n - 2) * SQ_BLK + tt) * DM + 512 + ch;
                const u32x2 gw = gq;
                const float o0 = (((y01.x - mean) * rstd) * lnw.x + lnb.x + y01.y) * bf2f(gw.x & 0xffffu), o1 = (((y01.z - mean) * rstd) * lnw.y + lnb.y + y01.w) * bf2f(gw.x >> 16);
                const float o2 = (((y23.x - mean) * rstd) * lnw.z + lnb.z + y23.y) * bf2f(gw.y & 0xffffu), o3 = (((y23.z - mean) * rstd) * lnw.w + lnb.w + y23.w) * bf2f(gw.y >> 16);
                u32x2 w; w.x = pk2(o0, o1); w.y = pk2(o2, o3); if (do_store) *(u32x2*)gp = w;
            }
            if (n >= 1 && n <= SQ_NBLK) gq = *(const u32x2*)(YC + ((size_t)b * SEQ + (n - 1) * SQ_BLK + tt) * DM + 512 + ch);
            __syncthreads();
        }
    } else {
        const int rg = lane >> 3, kq = lane & 7, r0 = 16 * wave + 2 * rg;
        f32x2 s0[4], s1[4];
#pragma unroll
        for (int i = 0; i < 4; ++i) { s0[i] = (f32x2){0.f, 0.f}; s1[i] = (f32x2){0.f, 0.f}; }
        for (int n = 0; n <= SQ_NBLK + 1; ++n) {
            if (n >= 1 && n <= SQ_NBLK) {
                const LAS float* vbase = (const LAS float*)(lds + ((n - 1) & 1) * SQ_BUF) + 8 * kq;
                LAS f32x4* yb = (LAS f32x4*)(lds + SQ_YOFF + ((n - 1) & 1) * SQ_YBUF) + r0 / 2;
#define SQ_LOAD(P, tt_) do { const LAS float* vb_ = vbase + (tt_) * SQ_VEC; P##ka = *(const LAS f32x4*)(vb_ + 64); P##kb = *(const LAS f32x4*)(vb_ + 68); P##wa = *(const LAS f32x4*)(vb_); P##wb = *(const LAS f32x4*)(vb_ + 4); \
        P##ba = *(const LAS f32x4*)(vb_ + 128); P##bb = *(const LAS f32x4*)(vb_ + 132); P##va = *(const LAS f32x4*)(vb_ + 192); P##vbv = *(const LAS f32x4*)(vb_ + 196); P##ra = *(const LAS f32x4*)(vb_ + 256); P##rb = *(const LAS f32x4*)(vb_ + 260); \
        P##vv = *(const LAS f32x2*)(vb_ - 8 * kq + 320 + r0); P##ct = vb_[384 - 8 * kq]; } while (0)
#define SQ_STEP(P, tt_) do { \
        const f32x2 kk[4] = {{P##ka.x, P##ka.y}, {P##ka.z, P##ka.w}, {P##kb.x, P##kb.y}, {P##kb.z, P##kb.w}}, ww[4] = {{P##wa.x, P##wa.y}, {P##wa.z, P##wa.w}, {P##wb.x, P##wb.y}, {P##wb.z, P##wb.w}}; \
        const f32x2 bq[4] = {{P##ba.x, P##ba.y}, {P##ba.z, P##ba.w}, {P##bb.x, P##bb.y}, {P##bb.z, P##bb.w}}, kv[4] = {{P##va.x, P##va.y}, {P##va.z, P##va.w}, {P##vbv.x, P##vbv.y}, {P##vbv.z, P##vbv.w}}; \
        const f32x2 rr[4] = {{P##ra.x, P##ra.y}, {P##ra.z, P##ra.w}, {P##rb.x, P##rb.y}, {P##rb.z, P##rb.w}}; \
        const f32x2 d0 = (s0[0] * kk[0] + s0[1] * kk[1]) + (s0[2] * kk[2] + s0[3] * kk[3]), d1 = (s1[0] * kk[0] + s1[1] * kk[1]) + (s1[2] * kk[2] + s1[3] * kk[3]); \
        f32x2 t0[4], t1[4]; \
        _Pragma("unroll") for (int i = 0; i < 4; ++i) { t0[i] = kv[i] * P##vv.x; t1[i] = kv[i] * P##vv.y; s0[i] = s0[i] * ww[i]; s1[i] = s1[i] * ww[i]; } \
        const float sa0 = -red8(d0.x + d0.y), sa1 = -red8(d1.x + d1.y); \
        f32x2 y0 = {0.f, 0.f}, y1 = {0.f, 0.f}; \
        _Pragma("unroll") for (int i = 0; i < 4; ++i) { s0[i] += t0[i] + bq[i] * sa0; s1[i] += t1[i] + bq[i] * sa1; y0 += s0[i] * rr[i]; y1 += s1[i] * rr[i]; } \
        const float ya = red8(y0.x + y0.y), yb1 = red8(y1.x + y1.y); \
        if (kq == 0) yb[(tt_) * 32] = (f32x4){ya, P##ct * P##vv.x, yb1, P##ct * P##vv.y}; } while (0)
                f32x4 Aka, Akb, Awa, Awb, Aba, Abb, Ava, Avbv, Ara, Arb, Bka, Bkb, Bwa, Bwb, Bba, Bbb, Bva, Bvbv, Bra, Brb; f32x2 Avv, Bvv; float Act, Bct;
                SQ_LOAD(A, 0);
#pragma unroll 1
                for (int tt = 0; tt < SQ_BLK; tt += 2) {
                    SQ_LOAD(B, tt + 1);
                    SQ_STEP(A, tt);
                    if (tt + 2 < SQ_BLK) SQ_LOAD(A, tt + 2);
                    SQ_STEP(B, tt + 1);
                }
            }
            __syncthreads();
        }
    }
}
constexpr int WY_T = 16, WY_NCH = SEQ / WY_T, WY_NP = 6;
constexpr int WY_AZ = 0, WY_AY1 = 2048, WY_AU = 4096, WY_AY2 = 5120, WY_AS = 6144, WY_VT = 10240, WY_PT = 12288, WY_SCR = 12544, WY_SLOT = 12544 + 5120, WY_FLAGS = WY_NP * WY_SLOT;
__device__ __forceinline__ int wy_perm_off(int t, int k) { const int n = k >> 4; return (n >> 1) * 1024 + t * 64 + ((k >> 2) & 3) * 16 + ((n & 1) * 4 + (k & 3)) * 2; }
__device__ __forceinline__ float red64(float v) { v += DPPF(v, 0xB1); v += DPPF(v, 0x4E); v += DPPF(v, 0x141); v += DPPF(v, 0x140); v += __shfl_xor(v, 16); v += __shfl_xor(v, 32); return v; }
__device__ __forceinline__ unsigned short bf1(float x) { return (unsigned short)(pk2(x, 0.f) & 0xffffu); }
#define WY_FENCE() do { asm volatile("s_waitcnt lgkmcnt(0)" ::: "memory"); __builtin_amdgcn_wave_barrier(); } while (0)
constexpr int WY_STGSZ = 6528, WY_STG = WY_NP * WY_SLOT + 64;
__device__ __forceinline__ void wy_issue(const Args& a, LAS unsigned char* stg, int b, int h, int c, int lane, float (&dec)[WY_T], float (&al)[WY_T], float (&rn)[WY_T]) {
    unsigned char* ws = a.ws;
    const bf16* PR = (const bf16*)(ws + WS_PRW); const float* DEC = (const float*)(ws + WS_DEC); const bf16* AL = (const bf16*)(ws + WS_AL); const float* CT = (const float*)(ws + WS_CT);
    const size_t tok0 = (size_t)b * SEQ + (size_t)c * WY_T; const int ch = h * 64 + lane;
#pragma unroll
    for (int j = 0; j < 7; ++j) { const int idx = j * 64 + lane;
        if (idx < 408) { const int row = idx >> 3, trel = row / 3, vec = row - 3 * trel; size_t tk = tok0 + trel; tk = (tk == 0) ? 1 : tk;
            __builtin_amdgcn_global_load_lds((const unsigned*)(PR + (tk - 1) * 1792 + vec * 512 + h * 64 + (idx & 7) * 8), (LAS unsigned*)(stg + j * 1024), 16, 0, 0); } }
#pragma unroll
    for (int t = 0; t < WY_T; ++t) { dec[t] = DEC[(tok0 + t) * 512 + ch]; al[t] = bf2f(AL[(tok0 + t) * 512 + ch]); rn[t] = CT[(tok0 + t) * 8 + h]; }
}
__device__ __forceinline__ void wy_build1(const Args& a, LAS unsigned char* slot, const LAS unsigned char* stg, int h, int c, int lane, const float (&dec)[WY_T], const float (&alr)[WY_T], const float (&rn)[WY_T]) {
    const int ch = h * 64 + lane;
    const float mixr = ((const float*)a.in[16])[ch], mixk = ((const float*)a.in[16])[512 + ch], mixv = ((const float*)a.in[16])[1024 + ch];
    const float k_k = ((const float*)a.in[22])[ch], k_a = ((const float*)a.in[23])[ch];
    float bv[WY_T], kv[WY_T], Pt[WY_T], vx[WY_T];
    const LAS unsigned short* sg = (const LAS unsigned short*)stg + lane;
    float pr = bf2f(sg[0]), pk = bf2f(sg[64]), pvv = bf2f(sg[128]);
    if (c == 0) { pr = 0.f; pk = 0.f; pvv = 0.f; }
    float Pcum = 1.f;
    LAS unsigned char* scr = slot + WY_SCR;
    const int po0 = wy_perm_off(0, lane);
#pragma unroll
    for (int t = 0; t < WY_T; t += 2) {
        const f32x2 cr = {bf2f(sg[(3 * (t + 1)) * 64]), bf2f(sg[(3 * (t + 2)) * 64])}, ck = {bf2f(sg[(3 * (t + 1) + 1) * 64]), bf2f(sg[(3 * (t + 2) + 1) * 64])}, cv = {bf2f(sg[(3 * (t + 1) + 2) * 64]), bf2f(sg[(3 * (t + 2) + 2) * 64])};
        const f32x2 prv = {pr, cr.x}, pkv = {pk, ck.x}, pvw = {pvv, cv.x};
        const f32x2 w = {dec[t], dec[t + 1]}, al = {alr[t], alr[t + 1]}, rnv = {rn[t], rn[t + 1]};
        const f32x2 r = cr + (prv - cr) * mixr, kx = ck + (pkv - ck) * mixk, vxx = cv + (pvw - cv) * mixv; pr = cr.y; pk = ck.y; pvv = cv.y;
        vx[t] = vxx.x; vx[t + 1] = vxx.y;
        const f32x2 kkn = kx * k_k * rnv, bvv = kkn * al, kvv = kx * ((al - 1.f) * k_a + 1.f);
        bv[t] = bvv.x; bv[t + 1] = bvv.y; kv[t] = kvv.x; kv[t + 1] = kvv.y;
        const float P0 = Pcum * w.x, P1 = P0 * w.y; const f32x2 Pprev = {Pcum, P0}, Pc = {P0, P1}; Pcum = P1;
        f32x2 invP; invP.x = __builtin_amdgcn_rcpf(P0); invP.y = __builtin_amdgcn_rcpf(P1); Pt[t] = invP.x; Pt[t + 1] = invP.y;
        const f32x2 az = -(kkn * Pprev), ay = r * Pc, bt = bvv * invP, kt2 = kvv * invP;
        const unsigned waz = pk2(az.x, az.y), way = pk2(ay.x, ay.y), wbt = pk2(bt.x, bt.y), wkt = pk2(kt2.x, kt2.y);
        const int po = po0 + t * 64;
        *(LAS unsigned short*)(slot + WY_AZ + po) = (unsigned short)waz; *(LAS unsigned short*)(slot + WY_AZ + po + 64) = (unsigned short)(waz >> 16);
        *(LAS unsigned short*)(slot + WY_AY1 + po) = (unsigned short)way; *(LAS unsigned short*)(slot + WY_AY1 + po + 64) = (unsigned short)(way >> 16);
        *(LAS unsigned short*)(scr + po) = (unsigned short)wbt; *(LAS unsigned short*)(scr + po + 64) = (unsigned short)(wbt >> 16);
        *(LAS unsigned short*)(scr + 2048 + po) = (unsigned short)wkt; *(LAS unsigned short*)(scr + 2048 + po + 64) = (unsigned short)(wkt >> 16);
    }
    { u32x4 w0, w1; w0.x = pk2(vx[0], vx[1]); w0.y = pk2(vx[2], vx[3]); w0.z = pk2(vx[4], vx[5]); w0.w = pk2(vx[6], vx[7]); w1.x = pk2(vx[8], vx[9]); w1.y = pk2(vx[10], vx[11]); w1.z = pk2(vx[12], vx[13]); w1.w = pk2(vx[14], vx[15]);
      *(LAS u32x4*)(slot + WY_VT + lane * 32) = w0; *(LAS u32x4*)(slot + WY_VT + lane * 32 + 16) = w1; }
    *(LAS float*)(slot + WY_PT + lane * 4) = Pcum;
#pragma unroll
    for (int g = 0; g < 4; ++g) { float bh4[4], kh4[4];
#pragma unroll
        for (int j = 0; j < 4; ++j) { const float sc = Pcum * Pt[4 * g + j]; bh4[j] = bv[4 * g + j] * sc; kh4[j] = kv[4 * g + j] * sc; }
        u32x4 w; w.x = pk2(bh4[0], bh4[1]); w.y = pk2(bh4[2], bh4[3]); w.z = pk2(kh4[0], kh4[1]); w.w = pk2(kh4[2], kh4[3]);
        *(LAS u32x4*)(slot + WY_AS + (lane >> 4) * 1024 + (lane & 15) * 64 + g * 16) = w; }
}
__device__ __forceinline__ void wy_build2(LAS unsigned char* slot, int lane) {
    LAS unsigned char* scr = slot + WY_SCR;
    const int row = lane & 15, g = lane >> 4; const int fo = row * 64 + g * 16;
    f32x4 m1 = {0.f, 0.f, 0.f, 0.f}, m2 = m1, m3 = m1, m4 = m1;
#pragma unroll
    for (int s = 0; s < 2; ++s) { const bf16x8 fa = *(const LAS bf16x8*)(slot + WY_AZ + s * 1024 + fo), fr = *(const LAS bf16x8*)(slot + WY_AY1 + s * 1024 + fo), fb = *(const LAS bf16x8*)(scr + s * 1024 + fo), fk = *(const LAS bf16x8*)(scr + 2048 + s * 1024 + fo);
        m1 = __builtin_amdgcn_mfma_f32_16x16x32_bf16(fa, fb, m1, 0, 0, 0); m2 = __builtin_amdgcn_mfma_f32_16x16x32_bf16(fa, fk, m2, 0, 0, 0);
        m3 = __builtin_amdgcn_mfma_f32_16x16x32_bf16(fr, fb, m3, 0, 0, 0); m4 = __builtin_amdgcn_mfma_f32_16x16x32_bf16(fr, fk, m4, 0, 0, 0); }
    WY_FENCE();
#pragma unroll
    for (int i = 0; i < 4; ++i) { const int t = 4 * g + i; const bool lo = row < t, le = row <= t;
        *(LAS float*)(scr + (t * 16 + row) * 4) = lo ? m1[i] : 0.f; *(LAS float*)(scr + 1024 + (t * 16 + row) * 4) = lo ? m2[i] : 0.f;
        *(LAS float*)(scr + 2048 + (t * 16 + row) * 4) = le ? m3[i] : 0.f; *(LAS float*)(scr + 3072 + (t * 16 + row) * 4) = le ? m4[i] : 0.f; }
    WY_FENCE();
    { float x[WY_T];
#pragma unroll
      for (int t = 0; t < WY_T; ++t) x[t] = (t == row) ? 1.f : 0.f;
#pragma unroll
      for (int t = 1; t < WY_T; ++t) { float acc = x[t];
#pragma unroll
          for (int s4 = 0; s4 < (t + 3) / 4; ++s4) { const f32x4 mr = *(const LAS f32x4*)(scr + (t * 16 + 4 * s4) * 4);
#pragma unroll
              for (int e = 0; e < 4; ++e) if (4 * s4 + e < t) acc += mr[e] * x[4 * s4 + e]; }
          x[t] = acc; }
      if (lane < 16) {
#pragma unroll
          for (int t = 0; t < WY_T; ++t) *(LAS float*)(scr + 4096 + (t * 16 + row) * 4) = x[t]; } }
    WY_FENCE();
    { const int t = lane >> 2, gq = lane & 3; f32x4 tm = {0.f, 0.f, 0.f, 0.f};
#pragma unroll
      for (int s4 = 0; s4 < 4; ++s4) { const f32x4 ti = *(const LAS f32x4*)(scr + 4096 + (t * 16 + 4 * s4) * 4);
#pragma unroll
          for (int e = 0; e < 4; ++e) { const f32x4 mr = *(const LAS f32x4*)(scr + 1024 + ((4 * s4 + e) * 16 + 4 * gq) * 4); tm += mr * ti[e]; } }
      const f32x4 ti4 = *(const LAS f32x4*)(scr + 4096 + (t * 16 + 4 * gq) * 4), m34 = *(const LAS f32x4*)(scr + 2048 + (t * 16 + 4 * gq) * 4), m44 = *(const LAS f32x4*)(scr + 3072 + (t * 16 + 4 * gq) * 4);
      u32x4 w; w.x = pk2(ti4.x, ti4.y); w.y = pk2(ti4.z, ti4.w); w.z = pk2(tm.x, tm.y); w.w = pk2(tm.z, tm.w); *(LAS u32x4*)(slot + WY_AU + t * 64 + gq * 16) = w;
      w.x = pk2(m34.x, m34.y); w.y = pk2(m34.z, m34.w); w.z = pk2(m44.x, m44.y); w.w = pk2(m44.z, m44.w); *(LAS u32x4*)(slot + WY_AY2 + t * 64 + gq * 16) = w; }
    WY_FENCE();
}
__device__ __forceinline__ void rw_wy(const Args& a, LAS unsigned char* lds, int bh, int tid) {
    const int b = bh >> 3, h = bh & 7, wave = __builtin_amdgcn_readfirstlane(tid >> 6), lane = tid & 63;
    LAS int* flags = (LAS int*)(lds + WY_FLAGS);
    static_assert(WY_STG + WY_NP * WY_STGSZ <= LDS_BYTES - 32, "WY LDS map");
    if (tid < 16) flags[tid] = (tid == 8 || tid == 9) ? 1 : 0;
    f32x4 ST[2][4];
    { LAS float* blk = (LAS float*)lds;
      if (wave == 2) rw_prep(a, blk, b, h, 0, lane); else if (wave == 3) rw_prep(a, blk + 8 * RW_VEC, b, h, 8, lane);
      asm volatile("s_waitcnt lgkmcnt(0)" ::: "memory");
      __syncthreads();
      if (wave < 2) { const int vl = lane & 15, g = lane >> 4; float* YB0 = (float*)(a.ws + WS_YB);
#pragma unroll
          for (int vt = 0; vt < 2; ++vt)
#pragma unroll
              for (int n = 0; n < 4; ++n) ST[vt][n] = (f32x4){0.f, 0.f, 0.f, 0.f};
#pragma unroll 1
          for (int tt = 0; tt < WY_T; ++tt) { const LAS float* vb = blk + tt * RW_VEC + 4 * g; f32x4 kk4[4], w4[4], bb4[4], kv4[4], r4[4];
#pragma unroll
              for (int n = 0; n < 4; ++n) { w4[n] = *(const LAS f32x4*)(vb + 16 * n); kk4[n] = *(const LAS f32x4*)(vb + 64 + 16 * n); bb4[n] = *(const LAS f32x4*)(vb + 128 + 16 * n); kv4[n] = *(const LAS f32x4*)(vb + 192 + 16 * n); r4[n] = *(const LAS f32x4*)(vb + 256 + 16 * n); }
#pragma unroll
              for (int vt = 0; vt < 2; ++vt) { const int v = 32 * wave + 16 * vt + vl; const float vv = blk[tt * RW_VEC + 320 + v];
                  f32x4 dv = ST[vt][0] * kk4[0] + ST[vt][1] * kk4[1] + ST[vt][2] * kk4[2] + ST[vt][3] * kk4[3]; float dd = (dv.x + dv.y) + (dv.z + dv.w);
                  dd += __shfl_xor(dd, 16); dd += __shfl_xor(dd, 32); const float sa = -dd;
                  f32x4 yv = {0.f, 0.f, 0.f, 0.f};
#pragma unroll
                  for (int n = 0; n < 4; ++n) { ST[vt][n] = ST[vt][n] * w4[n] + (kv4[n] * vv + bb4[n] * sa); yv += ST[vt][n] * r4[n]; }
                  float y = (yv.x + yv.y) + (yv.z + yv.w); y += __shfl_xor(y, 16); y += __shfl_xor(y, 32);
                  if (g == 0) YB0[((size_t)b * SEQ + tt) * 512 + h * 64 + v] = y; } } }
      __syncthreads(); }
    if (wave >= 2) {
        const int p = wave - 2; LAS unsigned char* slot = lds + p * WY_SLOT; LAS unsigned char* stg = lds + WY_STG + p * WY_STGSZ;
        float dec[WY_T], alr[WY_T], rn[WY_T];
        const int c_first = (p == 0) ? WY_NP : p;
        wy_issue(a, stg, b, h, c_first, lane, dec, alr, rn);
        for (int c = c_first; c < WY_NCH; c += WY_NP) {
            while (min(__hip_atomic_load(flags + 8, __ATOMIC_ACQUIRE, __HIP_MEMORY_SCOPE_WORKGROUP), __hip_atomic_load(flags + 9, __ATOMIC_ACQUIRE, __HIP_MEMORY_SCOPE_WORKGROUP)) < c - (WY_NP - 1)) __builtin_amdgcn_s_sleep(2);
            asm volatile("s_waitcnt vmcnt(0)" ::: "memory"); __builtin_amdgcn_wave_barrier();
            wy_build1(a, slot, stg, h, c, lane, dec, alr, rn);
            WY_FENCE();
            if (c + WY_NP < WY_NCH) wy_issue(a, stg, b, h, c + WY_NP, lane, dec, alr, rn);
            wy_build2(slot, lane);
            if (lane == 0) __hip_atomic_store(flags + p, c + 1, __ATOMIC_RELEASE, __HIP_MEMORY_SCOPE_WORKGROUP);
        }
    } else {
        float* YB = (float*)(a.ws + WS_YB);
        const int vl = lane & 15, g = lane >> 4;
        const f32x4 zero4 = {0.f, 0.f, 0.f, 0.f};
        for (int c = 1; c < WY_NCH; ++c) { const int p = c % WY_NP; const LAS unsigned char* slot = lds + p * WY_SLOT;
            while (__hip_atomic_load(flags + p, __ATOMIC_ACQUIRE, __HIP_MEMORY_SCOPE_WORKGROUP) != c + 1) __builtin_amdgcn_s_sleep(1);
            const int fo = vl * 64 + g * 16;
            f32x4 PT4[4];
#pragma unroll
            for (int n = 0; n < 4; ++n) PT4[n] = *(const LAS f32x4*)(slot + WY_PT + (16 * n + 4 * g) * 4);
            const bf16x8 az0 = *(const LAS bf16x8*)(slot + WY_AZ + fo), az1 = *(const LAS bf16x8*)(slot + WY_AZ + 1024 + fo), ay0 = *(const LAS bf16x8*)(slot + WY_AY1 + fo), ay1 = *(const LAS bf16x8*)(slot + WY_AY1 + 1024 + fo);
            const bf16x8 au = *(const LAS bf16x8*)(slot + WY_AU + fo), ay2 = *(const LAS bf16x8*)(slot + WY_AY2 + fo);
            const size_t tokg = (size_t)b * SEQ + (size_t)c * WY_T + 4 * g;
#pragma unroll
            for (int vt = 0; vt < 2; ++vt) { const int v = 32 * wave + 16 * vt + vl;
                u32x4 s0w, s1w; s0w.x = pk2(ST[vt][0].x, ST[vt][0].y); s0w.y = pk2(ST[vt][0].z, ST[vt][0].w); s0w.z = pk2(ST[vt][1].x, ST[vt][1].y); s0w.w = pk2(ST[vt][1].z, ST[vt][1].w);
                s1w.x = pk2(ST[vt][2].x, ST[vt][2].y); s1w.y = pk2(ST[vt][2].z, ST[vt][2].w); s1w.z = pk2(ST[vt][3].x, ST[vt][3].y); s1w.w = pk2(ST[vt][3].z, ST[vt][3].w);
                const bf16x8 sf0 = __builtin_bit_cast(bf16x8, s0w), sf1 = __builtin_bit_cast(bf16x8, s1w);
                f32x4 z = __builtin_amdgcn_mfma_f32_16x16x32_bf16(az0, sf0, zero4, 0, 0, 0); z = __builtin_amdgcn_mfma_f32_16x16x32_bf16(az1, sf1, z, 0, 0, 0);
                const u32x2 vq = *(const LAS u32x2*)(slot + WY_VT + v * 32 + g * 8);
                u32x4 f1w; f1w.x = pk2(z.x, z.y); f1w.y = pk2(z.z, z.w); f1w.z = vq.x; f1w.w = vq.y;
                const f32x4 u = __builtin_amdgcn_mfma_f32_16x16x32_bf16(au, __builtin_bit_cast(bf16x8, f1w), zero4, 0, 0, 0);
                u32x4 f2w; f2w.x = pk2(u.x, u.y); f2w.y = pk2(u.z, u.w); f2w.z = vq.x; f2w.w = vq.y; const bf16x8 f2 = __builtin_bit_cast(bf16x8, f2w);
                f32x4 y = __builtin_amdgcn_mfma_f32_16x16x32_bf16(ay0, sf0, zero4, 0, 0, 0); y = __builtin_amdgcn_mfma_f32_16x16x32_bf16(ay1, sf1, y, 0, 0, 0); y = __builtin_amdgcn_mfma_f32_16x16x32_bf16(ay2, f2, y, 0, 0, 0);
#pragma unroll
                for (int i = 0; i < 4; ++i) YB[(tokg + i) * 512 + h * 64 + v] = y[i];
#pragma unroll
                for (int n = 0; n < 4; ++n) { const bf16x8 as = *(const LAS bf16x8*)(slot + WY_AS + n * 1024 + fo); ST[vt][n] = __builtin_amdgcn_mfma_f32_16x16x32_bf16(as, f2, ST[vt][n] * PT4[n], 0, 0, 0); }
            }
            asm volatile("s_waitcnt lgkmcnt(0)" ::: "memory");
            if (lane == 0) __hip_atomic_store(flags + 8 + wave, c + 1, __ATOMIC_RELEASE, __HIP_MEMORY_SCOPE_WORKGROUP);
        }
    }
    __syncthreads();
}
struct PostIn { u32x4 ya, gate, vc, vp, rc, rp, kc, kp, al; f32x4 y0, y1; };
__device__ __forceinline__ void mixpost_load(PostIn& m, const bf16* YC, const float* YB, const bf16* PR, const bf16* AL, int row, int lane) {
    m.ya = *(const u32x4*)(YC + (size_t)row * DM + 8 * lane); m.gate = *(const u32x4*)(YC + (size_t)row * DM + 512 + 8 * lane);
    m.y0 = *(const f32x4*)(YB + (size_t)row * 512 + 8 * lane); m.y1 = *(const f32x4*)(YB + (size_t)row * 512 + 8 * lane + 4);
    const bool hp = (row & (SEQ - 1)) != 0; const size_t rp = hp ? (size_t)(row - 1) : (size_t)row;
    m.rc = *(const u32x4*)(PR + (size_t)row * 1792 + 8 * lane); m.kc = *(const u32x4*)(PR + (size_t)row * 1792 + 512 + 8 * lane); m.vc = *(const u32x4*)(PR + (size_t)row * 1792 + 1024 + 8 * lane);
    m.rp = *(const u32x4*)(PR + rp * 1792 + 8 * lane); m.kp = *(const u32x4*)(PR + rp * 1792 + 512 + 8 * lane); m.vp = *(const u32x4*)(PR + rp * 1792 + 1024 + 8 * lane);
    if (!hp) { m.rp = (u32x4){0u, 0u, 0u, 0u}; m.kp = m.rp; m.vp = m.rp; }
    m.al = *(const u32x4*)(AL + (size_t)row * 512 + 8 * lane);
}
__device__ __forceinline__ void mixpost_compute(const PostIn& m, const Args& a, bf16* YC, int row, int lane) {
    const float* ga = (const float*)a.in[15] + 8 * lane; const float* lw = (const float*)a.in[25] + 8 * lane; const float* lb = (const float*)a.in[26] + 8 * lane;
    const float* mr = (const float*)a.in[16] + 8 * lane; const float* mk = mr + 512; const float* mv = mr + 1024; const float* kap = (const float*)a.in[23] + 8 * lane; const float* rkp = (const float*)a.in[24] + 8 * lane;
    float f[8]; unpack8(m.ya, f); float s = 0.f;
#pragma unroll
    for (int e = 0; e < 8; ++e) s += f[e] * f[e];
    const float y[8] = {m.y0.x, m.y0.y, m.y0.z, m.y0.w, m.y1.x, m.y1.y, m.y1.z, m.y1.w}; float s1 = 0.f, s2 = 0.f;
#pragma unroll
    for (int e = 0; e < 8; ++e) { s1 += y[e]; s2 += y[e] * y[e]; }
    float rc[8], rp[8], kc[8], kp[8], al[8], vc[8], vp[8], gg[8]; unpack8(m.rc, rc); unpack8(m.rp, rp); unpack8(m.kc, kc); unpack8(m.kp, kp); unpack8(m.al, al); unpack8(m.vc, vc); unpack8(m.vp, vp); unpack8(m.gate, gg);
    float cs = 0.f;
#pragma unroll
    for (int e = 0; e < 8; ++e) { const float r = rc[e] + (rp[e] - rc[e]) * mr[e], kx = kc[e] + (kp[e] - kc[e]) * mk[e]; cs += r * kx * (1.f + (al[e] - 1.f) * kap[e]) * rkp[e]; }
#pragma unroll
    for (int o = 1; o < 64; o <<= 1) { s += __shfl_xor(s, o); if (o < 8) { s1 += __shfl_xor(s1, o); s2 += __shfl_xor(s2, o); cs += __shfl_xor(cs, o); } }
    const float rinv = rsqrtf(s * (1.f / 512.f) + 1e-6f);
    { u32x4 o; o.x = pk2(f[0] * rinv * ga[0], f[1] * rinv * ga[1]); o.y = pk2(f[2] * rinv * ga[2], f[3] * rinv * ga[3]); o.z = pk2(f[4] * rinv * ga[4], f[5] * rinv * ga[5]); o.w = pk2(f[6] * rinv * ga[6], f[7] * rinv * ga[7]); *(u32x4*)(YC + (size_t)row * DM + 8 * lane) = o; }
    const float mean = s1 * (1.f / 64.f), var = fmaxf(s2 * (1.f / 64.f) - mean * mean, 0.f), rstd = rsqrtf(var + 64e-5f);
    float o[8];
#pragma unroll
    for (int e = 0; e < 8; ++e) { const float v = vc[e] + (vp[e] - vc[e]) * mv[e]; o[e] = ((y[e] - mean) * rstd * lw[e] + lb[e] + cs * v) * gg[e]; }
    u32x4 w; w.x = pk2(o[0], o[1]); w.y = pk2(o[2], o[3]); w.z = pk2(o[4], o[5]); w.w = pk2(o[6], o[7]); *(u32x4*)(YC + (size_t)row * DM + 512 + 8 * lane) = w;
}
__device__ __forceinline__ void phase_mixpost(const Args& a, int lane, int gw, int NGW) {
    unsigned char* ws = a.ws; bf16* YC = (bf16*)(ws + WS_U); const float* YB = (const float*)(ws + WS_YB); const bf16* PR = (const bf16*)(ws + WS_PRW); const bf16* AL = (const bf16*)(ws + WS_AL);
    for (int row = gw; row < MT; row += 2 * NGW) { const int row2 = row + NGW; const bool has2 = row2 < MT;
        PostIn A, B; mixpost_load(A, YC, YB, PR, AL, row, lane); mixpost_load(B, YC, YB, PR, AL, has2 ? row2 : row, lane);
        mixpost_compute(A, a, YC, row, lane); if (has2) mixpost_compute(B, a, YC, row2, lane); }
}
#define XB_TMO      128
#define XB_XCNT(j)  (256  + 64 * (j))
#define XB_XSUB(j)  (1280 + 64 * (j))
#define XB_XGEN(j)  (2304 + 64 * (j))
#define XB_TOP      3328
#define XB_TOPGEN   3392
#define XCD_BAR_WORDS 3456
#define XB_SPIN_CAP (1u << 18)

__device__ __forceinline__ unsigned xb_ld(unsigned* p)              { return __hip_atomic_load(p, __ATOMIC_RELAXED, __HIP_MEMORY_SCOPE_AGENT); }
__device__ __forceinline__ unsigned xb_add(unsigned* p, unsigned v) { return __hip_atomic_fetch_add(p, v, __ATOMIC_RELAXED, __HIP_MEMORY_SCOPE_AGENT); }
__device__ __forceinline__ unsigned xb_xcc_id() { return (unsigned)__builtin_amdgcn_s_getreg((3 << 11) | 20) & 0xFu; }
#define XB_SPIN(cond, bar) do { unsigned _sp = 0; while (cond) { __builtin_amdgcn_s_sleep(1); \
    if ((++_sp & 255u) == 0u) { if (xb_ld(&(bar)[XB_TMO])) break; if (_sp > XB_SPIN_CAP) { atomicAdd(&(bar)[XB_TMO], 1u); break; } } } } while (0)

struct XcdBarrier {
    unsigned* bar; unsigned x;
    volatile LAS unsigned* st;
};

__device__ __forceinline__ XcdBarrier xcd_barrier_post(unsigned* bar, volatile LAS unsigned* st) {
    XcdBarrier b; b.bar = bar; b.x = xb_xcc_id(); b.st = st;
    if (threadIdx.x == 0) (void)xb_add(&bar[XB_XCNT(b.x)], 1u);
    return b;
}
__device__ __forceinline__ void xcd_barrier_complete(unsigned* bar, unsigned x, unsigned& nloc, unsigned& nx) {
    const unsigned G = gridDim.x * gridDim.y * gridDim.z;
    unsigned sum, cnt, mine, sp = 0u;
    for (;;) {
        sum = 0u; cnt = 0u; mine = 0u;
#pragma unroll
        for (unsigned j = 0; j < 16; ++j) { const unsigned c = xb_ld(&bar[XB_XCNT(j)]); sum += c; cnt += (c > 0u) ? 1u : 0u; mine = (j == x) ? c : mine; }
        if (sum == G) break;
        __builtin_amdgcn_s_sleep(1);
        if ((++sp & 255u) == 0u) { if (xb_ld(&bar[XB_TMO])) break; if (sp > XB_SPIN_CAP) { atomicAdd(&bar[XB_TMO], 1u); break; } }
    }
    nloc = mine > 0u ? mine : 1u; nx = cnt > 0u ? cnt : 1u;
}

__device__ __forceinline__ void xcd_barrier(const XcdBarrier& b) {
    asm volatile("s_waitcnt vmcnt(0)" ::: "memory");
    __syncthreads();
    if (threadIdx.x == 0) {
        unsigned* bar = b.bar;
        __builtin_amdgcn_s_waitcnt(0);
        unsigned nloc = b.st[0], nx = b.st[1];
        if (nloc == 0u) { xcd_barrier_complete(bar, b.x, nloc, nx); b.st[0] = nloc; b.st[1] = nx; }
        const unsigned old = xb_add(&bar[XB_XSUB(b.x)], 1u);
        const unsigned gen = old / nloc;
        if (old + 1u == (gen + 1u) * nloc) {
            __builtin_amdgcn_fence(__ATOMIC_RELEASE, "agent");
            asm volatile("s_waitcnt vmcnt(0)" ::: "memory");
            const unsigned og = xb_add(&bar[XB_TOP], 1u);
            const unsigned tg = og / nx;
            if (og + 1u == (tg + 1u) * nx) xb_add(&bar[XB_TOPGEN], 1u);
            else XB_SPIN(xb_ld(&bar[XB_TOPGEN]) == tg, bar);
            __builtin_amdgcn_fence(__ATOMIC_ACQUIRE, "agent");
            xb_add(&bar[XB_XGEN(b.x)], 1u);
            asm volatile("s_waitcnt vmcnt(0)" ::: "memory");
        } else {
            XB_SPIN(xb_ld(&bar[XB_XGEN(b.x)]) == gen, bar);
            __builtin_amdgcn_fence(__ATOMIC_ACQUIRE, "agent");
            asm volatile("s_waitcnt vmcnt(0)" ::: "memory");
        }
    }
    __syncthreads();
}

__global__ void __launch_bounds__(512, 2) mk_fwd(Args a) {
    extern __shared__ __attribute__((aligned(16))) unsigned char lds_raw[];
    LAS unsigned char* lds = (LAS unsigned char*)lds_raw;
    cg::grid_group grid = cg::this_grid();
    int tid = threadIdx.x, lane = tid & 63, wave = __builtin_amdgcn_readfirstlane(tid >> 6);
    const int G = gridDim.x; int gw = blockIdx.x * 8 + wave; const int NGW = G * 8;
#define RELAUNDER() do { tid = threadIdx.x; asm volatile("" : "+v"(tid)); lane = tid & 63; wave = __builtin_amdgcn_readfirstlane(tid >> 6); gw = blockIdx.x * 8 + wave; } while (0)
    unsigned char* ws = a.ws;
    const float* x = (const float*)a.in[0]; float* hbuf = a.out;
    const float* MOD = (const float*)(ws + WS_MOD);
    bf16* U = (bf16*)(ws + WS_U); bf16* ACT = (bf16*)(ws + WS_ACT);
    using pg8::Gemm; using pg8::StaticOrder;

#ifndef ONLY
#define ONLY -1
#endif
#define PH(n) (ONLY < 0 || ONLY == (n))
#ifndef SKIPMASK
#define SKIPMASK 0
#endif
#ifndef DUP
#define DUP -1
#endif
#define REP(n) for (int rep_ = 0; rep_ < ((DUP == (n)) ? 2 : 1); ++rep_)
    unsigned* barw = (unsigned*)(ws + WS_BAR);
    if (blockIdx.x == 0) for (int i = threadIdx.x; i < XCD_BAR_WORDS; i += 512) barw[i] = 0u;
    volatile LAS unsigned* bst = (volatile LAS unsigned*)(lds + LDS_BYTES - 32);
    if (threadIdx.x < 2) bst[threadIdx.x] = 0u;
    __syncthreads();
    if (PH(0)) REP(0) {
    if (blockIdx.x == 0 && threadIdx.x < 8) *((unsigned*)(a.ws + WS_CTR) + 16 * threadIdx.x) = 0u;
    phase_prologue(a, lds, tid, lane, wave); }
    grid.sync(); RELAUNDER();
    XcdBarrier xbar = xcd_barrier_post(barw, bst);
#if DUP == 99
    for (int i_ = 0; i_ < 16; ++i_) xcd_barrier(xbar);
#endif
    if (PH(1)) REP(1)
    phase_normmod(x, (const float*)a.in[5], MOD, 0, 1024, U, lane, gw, NGW);
    xcd_barrier(xbar); RELAUNDER();
    if (PH(2))
    REP(2)
    { Gemm g{U, (const bf16*)(ws + WS_WGU1), MT, 2 * FF, DM}; StaticOrder S; S.init(MT, 2 * FF, G, (int)blockIdx.x); pg8::EpiSwiglu E{ACT, FF};
      pg8::gemm_phase<pg8::EpiSwiglu, StaticOrder, true, true>(lds, g, S, E); }
    xcd_barrier(xbar); RELAUNDER();
    if (PH(3)) REP(3)
    { Gemm g{ACT, (const bf16*)(ws + WS_WD1), MT, DM, FF}; StaticOrder S; S.init(MT, DM, G, (int)blockIdx.x); pg8::EpiResid E{x, hbuf, MOD + 2048, 0.5f};
      pg8::gemm_phase<pg8::EpiResid, StaticOrder, true, true>(lds, g, S, E); }
    xcd_barrier(xbar); RELAUNDER();
    if (PH(1))
    phase_normmod(hbuf, (const float*)a.in[9], MOD, 3072, 4096, U, lane, gw, NGW);
    xcd_barrier(xbar); RELAUNDER();
    if (PH(5)) REP(5)
    { Gemm g{U, (const bf16*)(ws + WS_WIN), MT, 2560, DM}; StaticOrder S; S.init(MT, 2560, G, (int)blockIdx.x); pg8::EpiProj E{(bf16*)(ws + WS_PMLA), (bf16*)(ws + WS_PRW)};
      pg8::gemm_phase<pg8::EpiProj, StaticOrder, true, true>(lds, g, S, E); }
    xcd_barrier(xbar); RELAUNDER();
    if (PH(6)) REP(6)
    phase_mixprep(a, lane, gw, NGW);
    xcd_barrier(xbar); RELAUNDER();
    {
    if (PH(7)) REP(71)
    { Gemm g{(const bf16*)(ws + WS_QN), (const bf16*)(ws + WS_WUQ), MT, 768, 384 + (G >> 20)}; StaticOrder S; S.init(MT, 768, G, (int)blockIdx.x); pg8::EpiQ E{(bf16*)(ws + WS_QB), (const float*)(ws + WS_CS), 0.07216878364870322f * 1.4426950408889634f};
      pg8::gemm_phase<pg8::EpiQ, StaticOrder, true, true>(lds, g, S, E); }
    if (PH(8)) REP(72)
    { Gemm g{(const bf16*)(ws + WS_KVN), (const bf16*)(ws + WS_WK), MT, 512, 256 + (G >> 20)}; StaticOrder S; S.init(MT, 512, G, (int)blockIdx.x); pg8::EpiPlain E{(bf16*)(ws + WS_KN), 512};
      pg8::gemm_phase<pg8::EpiPlain, StaticOrder, true, true>(lds, g, S, E); }
    if (PH(9)) REP(73)
    { Gemm g{(const bf16*)(ws + WS_WV), (const bf16*)(ws + WS_KVN), 512, MT, 256 + (G >> 20)}; StaticOrder S; S.init(512, MT, G, (int)blockIdx.x); pg8::EpiVT E{(bf16*)(ws + WS_VT), (size_t)MT};
      pg8::gemm_phase<pg8::EpiVT, StaticOrder, true, true>(lds, g, S, E); }
    if (PH(10)) REP(74)
    { Gemm g{(const bf16*)(ws + WS_LIN), (const bf16*)(ws + WS_WLORA), MT, 1536, 256 + (G >> 20)}; StaticOrder S; S.init(MT, 1536, G, (int)blockIdx.x); pg8::EpiLora E{(float*)(ws + WS_DEC), (bf16*)(ws + WS_AL), U, (const float*)a.in[17], (const float*)a.in[19]};
      pg8::gemm_phase<pg8::EpiLora, StaticOrder, true, true>(lds, g, S, E); }
    }
    xcd_barrier(xbar); RELAUNDER();
    if (PH(11)) REP(30) {
        unsigned* qctr = (unsigned*)(ws + WS_CTR) + 64 * rep_;
        REP(21)
        for (int bh = blockIdx.x; bh < 64; bh += G) { rw_wy(a, lds, bh, tid); }
        volatile LAS unsigned* qslot = (volatile LAS unsigned*)(lds + LDS_BYTES - 16);
        const unsigned myq = xb_xcc_id() & 7u;
        for (;;) {
            if (tid == 0) { unsigned code = 0xffffffffu;
                for (unsigned s = 0; s < 8u; ++s) { const unsigned q = (myq + s) & 7u; const unsigned idx = atomicAdd(qctr + 16 * q, 1u); if (idx < 128u) { code = q * 128u + idx; break; } }
                *qslot = code; }
            __syncthreads();
            const unsigned code = *qslot;
            if (code == 0xffffffffu) break;
            const unsigned q = code >> 7, idx = code & 127u;
            const int u = 31 - (int)(idx >> 2), bh = (int)(4u * q + (idx & 3u));
            attn_unit((const bf16*)(ws + WS_QB), (const bf16*)(ws + WS_KN), (const bf16*)(ws + WS_KR), (const bf16*)(ws + WS_VT), U, lds, bh >> 2, bh & 3, u, tid, lane, wave);
        }
    }
    xcd_barrier(xbar); RELAUNDER();
    if (PH(13)) phase_mixpost(a, lane, gw, NGW);
    xcd_barrier(xbar); RELAUNDER();
    if (PH(3))
    { Gemm g{U, (const bf16*)(ws + WS_WOUT), MT, DM, DM}; StaticOrder S; S.init(MT, DM, G, (int)blockIdx.x); pg8::EpiResid E{hbuf, hbuf, MOD + 5120, 1.0f};
      pg8::gemm_phase<pg8::EpiResid, StaticOrder, true, true>(lds, g, S, E); }
    xcd_barrier(xbar); RELAUNDER();
    if (PH(1))
    phase_normmod(hbuf, (const float*)a.in[28], MOD, 6144, 7168, U, lane, gw, NGW);
    xcd_barrier(xbar); RELAUNDER();
    if (PH(2))
    { Gemm g{U, (const bf16*)(ws + WS_WGU2), MT, 2 * FF, DM}; StaticOrder S; S.init(MT, 2 * FF, G, (int)blockIdx.x); pg8::EpiSwiglu E{ACT, FF};
      pg8::gemm_phase<pg8::EpiSwiglu, StaticOrder, true, true>(lds, g, S, E); }
    xcd_barrier(xbar); RELAUNDER();
    if (PH(3))
    { Gemm g{ACT, (const bf16*)(ws + WS_WD2), MT, DM, FF}; StaticOrder S; S.init(MT, DM, G, (int)blockIdx.x); pg8::EpiResid E{hbuf, hbuf, MOD + 8192, 0.5f};
      pg8::gemm_phase<pg8::EpiResid, StaticOrder, true, true>(lds, g, S, E); }
    xcd_barrier(xbar); RELAUNDER();
    if (PH(15))
    phase_finalnorm(hbuf, (const float*)a.in[32], lane, gw, NGW);
}

extern "C" void kernel_launch(void* const* d_in, const int* in_sizes, int n_in, void* d_out, int out_size, void* d_ws, size_t ws_size, hipStream_t stream) {
    static int grid = 0;
    if (grid == 0) {
        int dev = 0, cus = 0, per_cu = 0;
        hipGetDevice(&dev); hipDeviceGetAttribute(&cus, hipDeviceAttributeMultiprocessorCount, dev);
        if (hipFuncSetAttribute((const void*)mk_fwd, hipFuncAttributeMaxDynamicSharedMemorySize, LDS_BYTES) != hipSuccess) { fprintf(stderr, "kernel_launch: hipFuncSetAttribute failed\n"); grid = -1; return; }
        if (hipOccupancyMaxActiveBlocksPerMultiprocessor(&per_cu, (const void*)mk_fwd, 512, LDS_BYTES) != hipSuccess || per_cu < 1) { fprintf(stderr, "kernel_launch: occupancy query gave %d\n", per_cu); per_cu = 1; }
        (void)hipGetLastError();
        grid = cus * per_cu;
        if (n_in != 33 || ws_size < (size_t)990 * MiB) { fprintf(stderr, "kernel_launch: unexpected n_in %d / ws %zu\n", n_in, ws_size); grid = -1; return; }
    }
    if (grid < 0) return;
    Args a{};
    for (int i = 0; i < 33; ++i) a.in[i] = d_in[i];
    a.out = (float*)d_out; a.ws = (unsigned char*)d_ws;
    void* args[] = {&a};
    hipError_t e = hipLaunchCooperativeKernel((const void*)mk_fwd, dim3(grid), dim3(512), args, LDS_BYTES, stream);
    if (e != hipSuccess) fprintf(stderr, "cooperative launch failed: %s (grid %d)\n", hipGetErrorString(e), grid);
}
```

```cpp
#include <hip/hip_runtime.h>
#include <hip/hip_cooperative_groups.h>
#include <cstdio>
#include <cstdint>
namespace cg = cooperative_groups;
namespace pg8 {
#define PG8_LAS __attribute__((address_space(3)))
typedef unsigned short bf16_t;
typedef short bf16x8 __attribute__((ext_vector_type(8)));
typedef float f32x4 __attribute__((ext_vector_type(4)));
typedef unsigned u32x4 __attribute__((ext_vector_type(4)));
constexpr int BM = 256, BK = 64, HALF = 128, HTB = HALF * BK * 2  , STAGE_BYTES = 8 * HTB, NXCD = 8, WGM = 8;

__host__ __device__ __forceinline__ int lds_byte(int r, int c) { const int st = (r >> 4) * 2 + (c >> 5), rr = r & 15, cc = c & 31, ob = rr * 64 + cc * 2; return st * 1024 + (ob ^ (((ob >> 9) & 1) << 5)); }
__host__ __device__ __forceinline__ void stage_rc(int b, int& R, int& C) { const int st = b / 1024, sb = b % 1024, swz = sb ^ (((sb >> 9) & 1) << 5); R = (st >> 1) * 16 + swz / 64; C = (st & 1) * 32 + (swz % 64) / 2; }
__host__ __device__ __forceinline__ int perm32(int rho) { const int n = rho >> 4, i = rho & 15; return 8 * (i >> 2) + 4 * n + (i & 3); }

struct Unit { int pm, pn; };
struct Gemm { const bf16_t* A; const bf16_t* Bt; int M, N, K; };

struct StaticOrder {
    int nM, nN, nwg, G, c;
    __host__ __device__ void init(int M, int N, int G_, int c_) { nM = M / BM; nN = N / BM; nwg = nM * nN; G = G_; c = c_; }
    __host__ __device__ bool next(int i, Unit& u) const {
        const long L = (long)i * G + c; if (L >= nwg) return false;
        int wgid = (int)L; { const int q = nwg / NXCD, r = nwg % NXCD, xcd = wgid % NXCD, off = wgid / NXCD; wgid = (xcd < r ? xcd * (q + 1) : r * (q + 1) + (xcd - r) * q) + off; }
        const int nig = WGM * nN, gid = wgid / nig, fm = gid * WGM, gsz = (nM - fm) < WGM ? (nM - fm) : WGM;
        u.pm = fm + ((wgid % nig) % gsz); u.pn = (wgid % nig) / gsz; return true;
    }
    __device__ __forceinline__ void a_ready(const Unit&) const {}
    __device__ __forceinline__ void done(const Unit&) const {}
};

__device__ __forceinline__ unsigned cvt_pk_bf16(float lo, float hi) { unsigned r; asm volatile("v_cvt_pk_bf16_f32 %0, %1, %2" : "=v"(r) : "v"(lo), "v"(hi)); return r; }
typedef float f32x2 __attribute__((ext_vector_type(2)));
__device__ __forceinline__ unsigned pkbf(float a, float b) { typedef __bf16 bf2_t __attribute__((ext_vector_type(2))); f32x2 v = {a, b}; return __builtin_bit_cast(unsigned, __builtin_convertvector(v, bf2_t)); }
typedef unsigned u32x2 __attribute__((ext_vector_type(2)));

struct EpiSwiglu {
    static constexpr bool PERM = true, AFTER_DRAIN = false;
    bf16_t* O; int ldo;
    __device__ __forceinline__ void operator()(const f32x4 (&acc)[2][2][4][2], const Unit& u, int wr, int wc, int fr, int fq) const {
        const int row0 = u.pm * BM + wr * 64 + fr, col0 = u.pn * 128 + wc * 32 + 8 * fq;
#pragma unroll
        for (int ai = 0; ai < 2; ++ai)
#pragma unroll
            for (int m = 0; m < 4; ++m) { bf16_t* rowp = O + (size_t)(row0 + ai * HALF + m * 16) * ldo + col0; float v[8];
#pragma unroll
                for (int bj = 0; bj < 2; ++bj) { const f32x4 g = acc[ai][bj][m][0], up = acc[ai][bj][m][1];
#pragma unroll
                    for (int e = 0; e < 4; ++e) v[4 * bj + e] = g[e] * __builtin_amdgcn_rcpf(1.f + __expf(-g[e])) * up[e]; }
                u32x4 w; w.x = pkbf(v[0], v[1]); w.y = pkbf(v[2], v[3]); w.z = pkbf(v[4], v[5]); w.w = pkbf(v[6], v[7]); *(u32x4*)rowp = w; }
    }
};
struct EpiResid {
    static constexpr bool PERM = false, AFTER_DRAIN = false;
    const float* base; float* out; const float* gate; float gs;
    __device__ __forceinline__ void operator()(const f32x4 (&acc)[2][2][4][2], const Unit& u, int wr, int wc, int fr, int fq) const {
        const int b = (u.pm * BM) >> 13; const float* gp = gate + (size_t)b * 9216;
        const int row0 = u.pm * BM + wr * 64 + fr, col0 = u.pn * BM + wc * 32 + 4 * fq;
        f32x4 gv[2][2];
#pragma unroll
        for (int bj = 0; bj < 2; ++bj)
#pragma unroll
            for (int n = 0; n < 2; ++n) gv[bj][n] = *(const f32x4*)(gp + col0 + bj * HALF + n * 16) * gs;
#pragma unroll
        for (int ai = 0; ai < 2; ++ai)
#pragma unroll
            for (int m = 0; m < 4; ++m) { const size_t off = (size_t)(row0 + ai * HALF + m * 16) * 1024 + col0;
#pragma unroll
                for (int bj = 0; bj < 2; ++bj)
#pragma unroll
                    for (int n = 0; n < 2; ++n) { const f32x4 bs = *(const f32x4*)(base + off + bj * HALF + n * 16); *(f32x4*)(out + off + bj * HALF + n * 16) = bs + gv[bj][n] * acc[ai][bj][m][n]; } }
    }
};
__device__ __forceinline__ void store8bf(bf16_t* p, const f32x4 v0, const f32x4 v1) { u32x4 w; w.x = pkbf(v0[0], v0[1]); w.y = pkbf(v0[2], v0[3]); w.z = pkbf(v1[0], v1[1]); w.w = pkbf(v1[2], v1[3]); *(u32x4*)p = w; }
struct EpiPlain {
    static constexpr bool PERM = true, AFTER_DRAIN = false;
    bf16_t* O; int ldc;
    __device__ __forceinline__ void operator()(const f32x4 (&acc)[2][2][4][2], const Unit& u, int wr, int wc, int fr, int fq) const {
        const int row0 = u.pm * BM + wr * 64 + fr, col0 = u.pn * BM + wc * 32 + 8 * fq;
#pragma unroll
        for (int ai = 0; ai < 2; ++ai)
#pragma unroll
            for (int m = 0; m < 4; ++m) { bf16_t* rowp = O + (size_t)(row0 + ai * HALF + m * 16) * ldc + col0;
#pragma unroll
                for (int bj = 0; bj < 2; ++bj) store8bf(rowp + bj * HALF, acc[ai][bj][m][0], acc[ai][bj][m][1]); }
    }
};
struct EpiProj {
    static constexpr bool PERM = true, AFTER_DRAIN = false;
    bf16_t* Pm; bf16_t* Pr;
    __device__ __forceinline__ void operator()(const f32x4 (&acc)[2][2][4][2], const Unit& u, int wr, int wc, int fr, int fq) const {
        bf16_t* bp; int ld, colt; if (u.pn < 3) { bp = Pm; ld = 768; colt = u.pn * BM; } else { bp = Pr; ld = 1792; colt = (u.pn - 3) * BM; }
        const int row0 = u.pm * BM + wr * 64 + fr, col0 = colt + wc * 32 + 8 * fq;
#pragma unroll
        for (int ai = 0; ai < 2; ++ai)
#pragma unroll
            for (int m = 0; m < 4; ++m) { bf16_t* rowp = bp + (size_t)(row0 + ai * HALF + m * 16) * ld + col0;
#pragma unroll
                for (int bj = 0; bj < 2; ++bj) store8bf(rowp + bj * HALF, acc[ai][bj][m][0], acc[ai][bj][m][1]); }
    }
};
struct EpiQ {
    static constexpr bool PERM = true, AFTER_DRAIN = false;
    bf16_t* O; const float* cs; float scale;
    __device__ __forceinline__ void operator()(const f32x4 (&acc)[2][2][4][2], const Unit& u, int wr, int wc, int fr, int fq) const {
        const int row0 = u.pm * BM + wr * 64 + fr, col0 = u.pn * BM + wc * 32 + 8 * fq;
#pragma unroll
        for (int bj = 0; bj < 2; ++bj) { const int c = col0 + bj * HALF, p = c % 192; const bool rope = p >= 128; const int j4 = ((p - 128) >> 3) * 4;
#pragma unroll
            for (int ai = 0; ai < 2; ++ai)
#pragma unroll
                for (int m = 0; m < 4; ++m) { const int row = row0 + ai * HALF + m * 16; f32x4 v0 = acc[ai][bj][m][0], v1 = acc[ai][bj][m][1];
                    if (rope) { const f32x4 cv = *(const f32x4*)(cs + (size_t)row * 64 + j4), sv = *(const f32x4*)(cs + (size_t)row * 64 + 32 + j4);
                        const f32x4 a = v0 * cv - v1 * sv, b2 = v1 * cv + v0 * sv; v0 = a; v1 = b2; }
                    store8bf(O + (size_t)row * 768 + c, v0 * scale, v1 * scale); } }
    }
};
struct EpiVT {
    static constexpr bool PERM = true, AFTER_DRAIN = false;
    bf16_t* O; size_t ldo;
    __device__ __forceinline__ void operator()(const f32x4 (&acc)[2][2][4][2], const Unit& u, int wr, int wc, int fr, int fq) const {
        const int row0 = u.pm * BM + wr * 64 + fr, col0 = u.pn * BM + wc * 32 + 8 * fq;
#pragma unroll
        for (int ai = 0; ai < 2; ++ai)
#pragma unroll
            for (int m = 0; m < 4; ++m) { bf16_t* rowp = O + (size_t)(row0 + ai * HALF + m * 16) * ldo;
#pragma unroll
                for (int bj = 0; bj < 2; ++bj)
#pragma unroll
                    for (int n = 0; n < 2; ++n) { const int c = col0 + bj * HALF + 4 * n, q4 = (c & 15) >> 2, pq = (q4 == 1) ? 2 : ((q4 == 2) ? 1 : q4), dst = (c & ~15) + 4 * pq;
                        const f32x4 v = acc[ai][bj][m][n]; u32x2 w; w.x = pkbf(v[0], v[1]); w.y = pkbf(v[2], v[3]); *(u32x2*)(rowp + dst) = w; } }
    }
};
struct EpiLora {
    static constexpr bool PERM = true, AFTER_DRAIN = false;
    float* DEC; bf16_t* AL; bf16_t* YC; const float* w0; const float* a0;
    __device__ __forceinline__ void operator()(const f32x4 (&acc)[2][2][4][2], const Unit& u, int wr, int wc, int fr, int fq) const {
        const int sect = u.pn >> 1; const int row0 = u.pm * BM + wr * 64 + fr, col0 = (u.pn & 1) * BM + wc * 32 + 8 * fq;
#pragma unroll
        for (int bj = 0; bj < 2; ++bj) { const int c = col0 + bj * HALF;
            f32x4 b0 = {0.f, 0.f, 0.f, 0.f}, b1 = b0;
            if (sect == 0) { b0 = *(const f32x4*)(w0 + c); b1 = *(const f32x4*)(w0 + c + 4); } else if (sect == 1) { b0 = *(const f32x4*)(a0 + c); b1 = *(const f32x4*)(a0 + c + 4); }
#pragma unroll
            for (int ai = 0; ai < 2; ++ai)
#pragma unroll
                for (int m = 0; m < 4; ++m) { const int row = row0 + ai * HALF + m * 16; f32x4 v0 = acc[ai][bj][m][0] + b0, v1 = acc[ai][bj][m][1] + b1;
                    if (sect == 0) {
#pragma unroll
                        for (int e = 0; e < 4; ++e) { { const float z = -v0[e]; const float sp = fmaxf(z, 0.f) + __logf(1.f + __expf(-fabsf(z))); v0[e] = __expf(-__expf(-sp - 0.5f)); }
                                                      { const float z = -v1[e]; const float sp = fmaxf(z, 0.f) + __logf(1.f + __expf(-fabsf(z))); v1[e] = __expf(-__expf(-sp - 0.5f)); } }
                        *(f32x4*)(DEC + (size_t)row * 512 + c) = v0; *(f32x4*)(DEC + (size_t)row * 512 + c + 4) = v1;
                    } else if (sect == 1) {
#pragma unroll
                        for (int e = 0; e < 4; ++e) { v0[e] = __builtin_amdgcn_rcpf(1.f + __expf(-v0[e])); v1[e] = __builtin_amdgcn_rcpf(1.f + __expf(-v1[e])); }
                        store8bf(AL + (size_t)row * 512 + c, v0, v1);
                    } else store8bf(YC + (size_t)row * 1024 + 512 + c, v0, v1);
                } }
    }
};
template <class Epi, class Sched, bool ALIGN_EPI = false, bool SP2 = false>
__device__ __forceinline__ void gemm_phase(PG8_LAS unsigned char* lds, const Gemm g, const Sched& S, const Epi& E) {
    int tid_l = threadIdx.x; asm volatile("" : "+v"(tid_l));
    const int tid = tid_l, wid = __builtin_amdgcn_readfirstlane(tid >> 6), lane = tid & 63, wr = wid >> 2, wc = wid & 3, fr = lane & 15, fq = lane >> 4;
    const int K = g.K, nt = K / BK;
    unsigned voffA[2], voffB[2];
#pragma unroll
    for (int i = 0; i < 2; ++i) { int R, C; stage_rc(tid * 16 + i * 8192, R, C); const int Rb = Epi::PERM ? ((R & ~31) + perm32(R & 31)) : R;
        voffA[i] = (unsigned)(R * K + C) * 2u; voffB[i] = (unsigned)(Rb * K + C) * 2u; }
    const size_t kstep = (size_t)(BK * 2);
    const size_t hstep = (size_t)HALF * K * 2;
    const size_t tstep = 2 * hstep;
    const unsigned ldsw = (unsigned)wid * 1024u;
    const int aoff = lds_byte(wr * 64 + fr, fq * 8), boff = lds_byte(wc * 32 + fr, fq * 8);
#define PG8_SA(b, h) (((b) * 2 + (h)) * HTB)
#define PG8_SB(b, h) ((4 + (b) * 2 + (h)) * HTB)
#define PG8_STAGE(bufoff, gbase, voff) do { _Pragma("unroll") for (int _i = 0; _i < 2; ++_i) \
        __builtin_amdgcn_global_load_lds((const unsigned*)((const char*)(gbase) + (voff)[_i]), (PG8_LAS unsigned*)(lds + (bufoff) + ldsw + _i * 8192), 16, 0, 0); } while (0)
#define PG8_LDA(dst, b, h) do { _Pragma("unroll") for (int m = 0; m < 4; ++m) _Pragma("unroll") for (int k = 0; k < 2; ++k) dst[m][k] = *(const PG8_LAS bf16x8*)(lds + PG8_SA(b, h) + aoff + m * 2048 + k * 1024); } while (0)
#define PG8_LDB(dst, b, h) do { _Pragma("unroll") for (int n = 0; n < 2; ++n) _Pragma("unroll") for (int k = 0; k < 2; ++k) dst[n][k] = *(const PG8_LAS bf16x8*)(lds + PG8_SB(b, h) + boff + n * 2048 + k * 1024); } while (0)
#define PG8_MMA(ai, bj, At, Bt) do { __builtin_amdgcn_s_setprio(1); _Pragma("unroll") for (int m = 0; m < 4; ++m) _Pragma("unroll") for (int n = 0; n < 2; ++n) _Pragma("unroll") for (int k = 0; k < 2; ++k) \
        acc[ai][bj][m][n] = __builtin_amdgcn_mfma_f32_16x16x32_bf16(Bt[n][k], At[m][k], acc[ai][bj][m][n], 0, 0, 0); __builtin_amdgcn_s_setprio(0); } while (0)
#define PG8_WAIT_V(n) asm volatile("s_waitcnt vmcnt(" #n ")" ::: "memory")
#define PG8_WAIT_L(n) asm volatile("s_waitcnt lgkmcnt(" #n ")" ::: "memory")
#define PG8_BAR __builtin_amdgcn_s_barrier()
#define PG8_SCHED __builtin_amdgcn_sched_barrier(0)
    Unit cur, nxt; int ui = 0;
    if (!S.next(0, cur)) return;
    f32x4 acc[2][2][4][2];
#pragma unroll
    for (int a = 0; a < 2; ++a)
#pragma unroll
        for (int b = 0; b < 2; ++b)
#pragma unroll
            for (int m = 0; m < 4; ++m)
#pragma unroll
                for (int n = 0; n < 2; ++n) acc[a][b][m][n] = (f32x4){0.f, 0.f, 0.f, 0.f};
    bf16x8 At[4][2], B0[2][2], B1[2][2];
    const char* cA = (const char*)g.A + (size_t)cur.pm * tstep; const char* cB = (const char*)g.Bt + (size_t)cur.pn * tstep;
    S.a_ready(cur);
    if constexpr (SP2) {
        PG8_STAGE(PG8_SB(0, 0), cB, voffB); PG8_STAGE(PG8_SB(0, 1), cB + hstep, voffB); PG8_STAGE(PG8_SA(0, 0), cA, voffA); PG8_STAGE(PG8_SA(0, 1), cA + hstep, voffA);
        if (wr == 1) PG8_BAR;
        PG8_WAIT_V(2); PG8_BAR;
        PG8_STAGE(PG8_SB(1, 0), cB + kstep, voffB); PG8_STAGE(PG8_SA(1, 0), cA + kstep, voffA); PG8_STAGE(PG8_SB(1, 1), cB + hstep + kstep, voffB);
        PG8_WAIT_V(6); PG8_BAR;
    } else {
        PG8_STAGE(PG8_SB(0, 0), cB, voffB); PG8_STAGE(PG8_SA(0, 0), cA, voffA); PG8_STAGE(PG8_SB(0, 1), cB + hstep, voffB); PG8_STAGE(PG8_SA(0, 1), cA + hstep, voffA);
        if (wr == 1) PG8_BAR;
        PG8_WAIT_V(4); PG8_BAR;
        PG8_STAGE(PG8_SB(1, 0), cB + kstep, voffB); PG8_STAGE(PG8_SA(1, 0), cA + kstep, voffA); PG8_STAGE(PG8_SB(1, 1), cB + hstep + kstep, voffB);
        PG8_WAIT_V(6); PG8_BAR;
    }
    for (;;) {
        const bool has_next = S.next(ui + 1, nxt);
        const char* nA = has_next ? (const char*)g.A + (size_t)nxt.pm * tstep : cA; const char* nB = has_next ? (const char*)g.Bt + (size_t)nxt.pn * tstep : cB;
        for (int t = 0; t < nt; t += 2) {
            const bool last = (t == nt - 2);
            const char* a1 = cA + (size_t)(t + 1) * kstep;
            const char* a2 = last ? nA : cA + (size_t)(t + 2) * kstep; const char* b2 = last ? nB : cB + (size_t)(t + 2) * kstep;
            const char* a3 = a2 + kstep; const char* b3 = b2 + kstep;
            if (last && has_next) S.a_ready(nxt);
            if constexpr (SP2) {
            PG8_LDB(B0, 0, 0); PG8_LDB(B1, 0, 1); PG8_SCHED; PG8_LDA(At, 0, 0); PG8_STAGE(PG8_SA(1, 1), a1 + hstep, voffA);
            PG8_WAIT_V(8); PG8_WAIT_L(0); PG8_BAR; PG8_MMA(0, 0, At, B0); PG8_MMA(0, 1, At, B1); PG8_BAR; PG8_SCHED;
            PG8_LDA(At, 0, 1); PG8_STAGE(PG8_SB(0, 0), b2, voffB); PG8_STAGE(PG8_SB(0, 1), b2 + hstep, voffB); PG8_STAGE(PG8_SA(0, 0), a2, voffA);
            PG8_WAIT_V(8); PG8_WAIT_L(0); PG8_BAR; PG8_MMA(1, 0, At, B0); PG8_MMA(1, 1, At, B1); PG8_BAR; PG8_SCHED;
            PG8_LDB(B0, 1, 0); PG8_LDB(B1, 1, 1); PG8_SCHED; PG8_LDA(At, 1, 0); PG8_STAGE(PG8_SA(0, 1), a2 + hstep, voffA);
            PG8_WAIT_V(8); PG8_WAIT_L(0); PG8_BAR; PG8_MMA(0, 0, At, B0); PG8_MMA(0, 1, At, B1); PG8_BAR; PG8_SCHED;
            PG8_LDA(At, 1, 1); PG8_STAGE(PG8_SB(1, 0), b3, voffB); PG8_STAGE(PG8_SB(1, 1), b3 + hstep, voffB); PG8_STAGE(PG8_SA(1, 0), a3, voffA);
            PG8_WAIT_V(8); PG8_WAIT_L(0); PG8_BAR; PG8_MMA(1, 0, At, B0); PG8_MMA(1, 1, At, B1); PG8_BAR; PG8_SCHED;
            } else {
            PG8_LDB(B0, 0, 0); PG8_SCHED; PG8_LDA(At, 0, 0); PG8_STAGE(PG8_SA(1, 1), a1 + hstep, voffA);
            PG8_WAIT_L(8); PG8_BAR; PG8_WAIT_L(0); PG8_MMA(0, 0, At, B0); PG8_BAR; PG8_SCHED;
            PG8_LDB(B1, 0, 1); PG8_STAGE(PG8_SB(0, 0), b2, voffB);
            PG8_BAR; PG8_WAIT_L(0); PG8_MMA(0, 1, At, B1); PG8_BAR;
            PG8_LDA(At, 0, 1); PG8_STAGE(PG8_SA(0, 0), a2, voffA);
            PG8_BAR; PG8_WAIT_L(0); PG8_MMA(1, 0, At, B0); PG8_BAR; PG8_SCHED;
            PG8_STAGE(PG8_SB(0, 1), b2 + hstep, voffB);
            PG8_WAIT_V(6); PG8_BAR; PG8_MMA(1, 1, At, B1); PG8_BAR;
            PG8_LDB(B0, 1, 0); PG8_SCHED; PG8_LDA(At, 1, 0); PG8_STAGE(PG8_SA(0, 1), a2 + hstep, voffA);
            PG8_WAIT_L(8); PG8_BAR; PG8_WAIT_L(0); PG8_MMA(0, 0, At, B0); PG8_BAR; PG8_SCHED;
            PG8_LDB(B1, 1, 1); PG8_STAGE(PG8_SB(1, 0), b3, voffB);
            PG8_BAR; PG8_WAIT_L(0); PG8_MMA(0, 1, At, B1); PG8_BAR;
            PG8_LDA(At, 1, 1); PG8_STAGE(PG8_SA(1, 0), a3, voffA);
            PG8_BAR; PG8_WAIT_L(0); PG8_MMA(1, 0, At, B0); PG8_BAR; PG8_SCHED;
            PG8_STAGE(PG8_SB(1, 1), b3 + hstep, voffB);
            PG8_WAIT_V(6); PG8_BAR; PG8_MMA(1, 1, At, B1); PG8_BAR;
            }
        }
        if constexpr (ALIGN_EPI) { if (wr == 0) PG8_BAR; }
        if constexpr (!Epi::AFTER_DRAIN) { E(acc, cur, wr, wc, fr, fq); S.done(cur); }
        if (!has_next) break;
#pragma unroll
        for (int a = 0; a < 2; ++a)
#pragma unroll
            for (int b = 0; b < 2; ++b)
#pragma unroll
                for (int m = 0; m < 4; ++m)
#pragma unroll
                    for (int n = 0; n < 2; ++n) acc[a][b][m][n] = (f32x4){0.f, 0.f, 0.f, 0.f};
        cur = nxt; cA = nA; cB = nB; ++ui;
        if constexpr (ALIGN_EPI) { if (wr == 1) PG8_BAR; }
    }
    PG8_WAIT_V(0);
    if constexpr (!ALIGN_EPI) { if (wr == 0) PG8_BAR; }
    PG8_BAR;
    if constexpr (Epi::AFTER_DRAIN) { E.fused(acc, cur, wr, wc, fr, fq, lds, wid, lane); S.done(cur); }
#undef PG8_SA
#undef PG8_SB
#undef PG8_STAGE
#undef PG8_LDA
#undef PG8_LDB
#undef PG8_MMA
#undef PG8_WAIT_V
#undef PG8_WAIT_L
#undef PG8_BAR
#undef PG8_SCHED
}
}
#define LAS __attribute__((address_space(3)))
typedef unsigned short bf16;
typedef float f32x4 __attribute__((ext_vector_type(4)));
typedef float f32x2 __attribute__((ext_vector_type(2)));
typedef float f32x16 __attribute__((ext_vector_type(16)));
typedef short bf16x8 __attribute__((ext_vector_type(8)));
typedef unsigned u32x4 __attribute__((ext_vector_type(4)));
typedef unsigned u32x2 __attribute__((ext_vector_type(2)));
constexpr int NB = 8, SEQ = 8192, DM = 1024, MT = NB * SEQ, FF = 2816, NMODC = 9216;
constexpr int RW_T = 128, RW_NC = SEQ / RW_T;
constexpr int LDS_BYTES = 147456;
constexpr size_t MiB = 1u << 20;
constexpr size_t WS_MOD = 0, WS_CTR = 1024 * 1024, WS_BAR = 1024 * 1024 + 65536;
constexpr size_t WS_WGU1 = 2 * MiB, WS_WD1 = 13 * MiB, WS_WIN = 19 * MiB, WS_WUQ = 24 * MiB, WS_WK = 25 * MiB, WS_WV = 25 * MiB + 512 * 1024, WS_WLORA = 26 * MiB, WS_WOUT = 27 * MiB, WS_WGU2 = 29 * MiB, WS_WD2 = 40 * MiB;
constexpr size_t WS_U = 50 * MiB;
constexpr size_t WS_ACT = 178 * MiB;
constexpr size_t WS_QN = 178 * MiB, WS_KVN = 226 * MiB, WS_LIN = 258 * MiB, WS_CS = 290 * MiB, WS_KR = 306 * MiB, WS_QB = 314 * MiB, WS_KN = 410 * MiB, WS_VT = 474 * MiB;
constexpr size_t WS_PRW = 538 * MiB, WS_PMLA = 762 * MiB, WS_DEC = 858 * MiB;
constexpr size_t WS_YB = 858 * MiB  , WS_CT = 986 * MiB;
constexpr size_t WS_G = 178 * MiB, WS_J = 242 * MiB, WS_SST = 314 * MiB, WS_AL = 762 * MiB;

__device__ __forceinline__ float bf2f(unsigned h) { return __uint_as_float(h << 16); }
__device__ __forceinline__ unsigned pk2(float a, float b) { typedef __bf16 bf2_t __attribute__((ext_vector_type(2))); f32x2 v = {a, b}; return __builtin_bit_cast(unsigned, __builtin_convertvector(v, bf2_t)); }
__device__ __forceinline__ float wave_sum(float v) {
#pragma unroll
    for (int o = 1; o < 64; o <<= 1) v += __shfl_xor(v, o);
    return v;
}
__device__ __forceinline__ void unpack8(const u32x4 w, float* f) { f[0] = bf2f(w.x & 0xffffu); f[1] = bf2f(w.x >> 16); f[2] = bf2f(w.y & 0xffffu); f[3] = bf2f(w.y >> 16); f[4] = bf2f(w.z & 0xffffu); f[5] = bf2f(w.z >> 16); f[6] = bf2f(w.w & 0xffffu); f[7] = bf2f(w.w >> 16); }

struct Args { const void* in[33]; float* out; unsigned char* ws; };

__device__ __forceinline__ const float* wsrc(const Args& a, int job, int p, int& ldw) {
    switch (job) {
    case 0: case 6: { const int pn = p >> 8, r = p & 255, bj = r >> 7, wc = (r >> 5) & 3, fq = (r >> 3) & 3, n = (r >> 2) & 1, e = r & 3; ldw = FF; const float* g = (const float*)a.in[job == 0 ? 6 : 29]; const float* u = (const float*)a.in[job == 0 ? 7 : 30]; return (n ? u : g) + 128 * pn + 32 * wc + 8 * fq + 4 * bj + e; }
    case 1: ldw = DM; return (const float*)a.in[8] + p;
    case 7: ldw = DM; return (const float*)a.in[31] + p;
    case 2: ldw = 2496; return p < 704 ? (const float*)a.in[10] + p : (p < 768 ? nullptr : (const float*)a.in[10] + (p - 64));
    case 3: { ldw = 768; const int h = p / 192, pp = p % 192; if (pp < 128) return (const float*)a.in[12] + h * 192 + pp; const int q = pp - 128, j = q >> 3, e = q & 7; const int dim = e < 4 ? 4 * j + e : 32 + 4 * j + (e - 4); return (const float*)a.in[12] + h * 192 + 128 + dim; }
    case 4: ldw = 1024; return (const float*)a.in[14] + (p >> 7) * 256 + (p & 127);
    case 5: ldw = 1024; return (const float*)a.in[14] + (p >> 7) * 256 + 128 + (p & 127);
    default: ldw = DM; return (const float*)a.in[27] + p;
    }
}
__device__ __forceinline__ void p0_transpose_item(const Args& a, int job, int K, int nblk, bf16* WT, LAS float* scr, int item, int lane) {
    const int kb = item / nblk, nb = item % nblk, k0 = 64 * kb, n0 = 32 * nb;
    int ldw; const float* src = wsrc(a, job, n0 + (lane & 31), ldw);
    float tv[32];
#pragma unroll
    for (int i = 0; i < 32; ++i) { const int kk = 2 * i + (lane >> 5); tv[i] = src ? src[(size_t)(k0 + kk) * ldw] : 0.f; }
#pragma unroll
    for (int i = 0; i < 32; ++i) { const int kk = 2 * i + (lane >> 5); scr[kk * 33 + (lane & 31)] = tv[i]; }
    asm volatile("s_waitcnt lgkmcnt(0)" ::: "memory");
    const int c = lane & 7;
#pragma unroll
    for (int j = 0; j < 4; ++j) { const int n = (lane >> 3) + 8 * j; const LAS float* s = scr + (8 * c) * 33 + n;
        u32x4 o; o.x = pk2(s[0 * 33], s[1 * 33]); o.y = pk2(s[2 * 33], s[3 * 33]); o.z = pk2(s[4 * 33], s[5 * 33]); o.w = pk2(s[6 * 33], s[7 * 33]);
        *(u32x4*)(WT + (size_t)(n0 + n) * K + k0 + 8 * c) = o; }
    asm volatile("s_waitcnt lgkmcnt(0)" ::: "memory");
}
__device__ __forceinline__ void phase_prologue(const Args& a, LAS unsigned char* lds, int tid, int lane, int wave) {
    unsigned char* ws = a.ws;
    __syncthreads();
    if (blockIdx.x < NMODC / 64) {
        LAS float* cact = (LAS float*)lds; LAS float* red = (LAS float*)(lds + 32768);
        const float* c = (const float*)a.in[1];
        for (int i = tid; i < NB * DM; i += 512) { const float v = c[i]; cact[i] = v / (1.f + __expf(-v)); }
        __syncthreads();
        const float* wm = (const float*)a.in[3]; const int col = blockIdx.x * 64 + lane; float acc[NB];
#pragma unroll
        for (int b = 0; b < NB; ++b) acc[b] = 0.f;
        for (int k0 = wave * 128; k0 < wave * 128 + 128; k0 += 16) { float wv[16];
#pragma unroll
            for (int i = 0; i < 16; ++i) wv[i] = wm[(size_t)(k0 + i) * NMODC + col];
#pragma unroll
            for (int i = 0; i < 16; ++i)
#pragma unroll
                for (int b = 0; b < NB; ++b) acc[b] += cact[b * DM + k0 + i] * wv[i]; }
#pragma unroll
        for (int b = 0; b < NB; ++b) red[(wave * NB + b) * 64 + lane] = acc[b];
        __syncthreads();
        { float s = ((const float*)a.in[4])[col];
#pragma unroll
          for (int w = 0; w < 8; ++w) s += red[(w * NB + wave) * 64 + lane];
          ((float*)(ws + WS_MOD))[(size_t)wave * NMODC + col] = s; }
        __syncthreads();
    }
    const int NMW = NMODC / 64;
    const bool split = (int)gridDim.x >= NMW + 96;
    const int gw = split ? ((int)blockIdx.x - NMW) * 8 + wave : (int)blockIdx.x * 8 + wave, NGW = split ? ((int)gridDim.x - NMW) * 8 : (int)gridDim.x * 8;
    LAS float* scr = (LAS float*)(lds + wave * 16384);
    const int jobK[9] = {DM, FF, DM, 384, 256, 256, DM, FF, DM};
    const int jobN[9] = {2 * FF, DM, 2560, 768, 512, 512, 2 * FF, DM, DM};
    const size_t jobO[9] = {WS_WGU1, WS_WD1, WS_WIN, WS_WUQ, WS_WK, WS_WV, WS_WGU2, WS_WD2, WS_WOUT};
#pragma unroll
    for (int j = 0; j < 9; ++j) { const int K = jobK[j], nblk = jobN[j] / 32, nit = (K / 64) * nblk;
        if (gw >= 0) for (int it = gw; it < nit; it += NGW) p0_transpose_item(a, j, K, nblk, (bf16*)(ws + jobO[j]), scr, it, lane); }
    { bf16* WL = (bf16*)(ws + WS_WLORA); const float* w2 = (const float*)a.in[18]; const float* a2 = (const float*)a.in[20]; const float* g2 = (const float*)a.in[21];
      if (gw >= 0) for (int i = gw * 64 + lane; i < 1536 * 256; i += NGW * 64) { const int c = i >> 8, k = i & 255; float v = 0.f;
          if (c < 512) { if (k < 64) v = w2[k * 512 + c]; } else if (c < 1024) { if (k >= 64 && k < 128) v = a2[(k - 64) * 512 + (c - 512)]; } else { if (k >= 128) v = g2[(k - 128) * 512 + (c - 1024)]; }
          WL[i] = (bf16)(pk2(v, 0.f) & 0xffffu); } }
}

__device__ __forceinline__ void phase_normmod(const float* X, const float* g, const float* mod, int sh_off, int sc_off, bf16* U, int lane, int gw, int NGW, int rowEnd = MT) {
#pragma unroll 1
    for (int row = gw; row < rowEnd; row += 2 * NGW) { const int row2 = row + NGW;
        const bool has2 = row2 < rowEnd; const int rB = has2 ? row2 : row;
        const f32x4* xa = (const f32x4*)(X + (size_t)row * DM) + lane; const f32x4* xb = (const f32x4*)(X + (size_t)rB * DM) + lane; f32x4 va[4], vb[4]; float sa = 0.f, sb = 0.f;
#pragma unroll
        for (int j = 0; j < 4; ++j) { va[j] = xa[64 * j]; vb[j] = xb[64 * j]; }
#pragma unroll
        for (int j = 0; j < 4; ++j) { sa += (va[j].x * va[j].x + va[j].y * va[j].y) + (va[j].z * va[j].z + va[j].w * va[j].w); sb += (vb[j].x * vb[j].x + vb[j].y * vb[j].y) + (vb[j].z * vb[j].z + vb[j].w * vb[j].w); }
#pragma unroll
        for (int o = 1; o < 64; o <<= 1) { sa += __shfl_xor(sa, o); sb += __shfl_xor(sb, o); }
        const float ra = rsqrtf(sa * (1.f / DM) + 1e-6f), rb = rsqrtf(sb * (1.f / DM) + 1e-6f);
        const float* ma = mod + (size_t)(row >> 13) * NMODC; const float* mb = mod + (size_t)(rB >> 13) * NMODC;
#pragma unroll
        for (int j = 0; j < 4; ++j) { const int col = 4 * lane + 256 * j; const f32x4 gv = *(const f32x4*)(g + col);
            { const f32x4 sc = *(const f32x4*)(ma + sc_off + col), sh = *(const f32x4*)(ma + sh_off + col); const f32x4 o = (va[j] * ra * gv) * (sc + 1.f) + sh; u32x2 w; w.x = pk2(o.x, o.y); w.y = pk2(o.z, o.w); *(u32x2*)(U + (size_t)row * DM + col) = w; }
            if (has2) { const f32x4 sc = *(const f32x4*)(mb + sc_off + col), sh = *(const f32x4*)(mb + sh_off + col); const f32x4 o = (vb[j] * rb * gv) * (sc + 1.f) + sh; u32x2 w; w.x = pk2(o.x, o.y); w.y = pk2(o.z, o.w); *(u32x2*)(U + (size_t)rB * DM + col) = w; } }
    }
}
__device__ __forceinline__ void phase_finalnorm(float* X, const float* g, int lane, int gw, int NGW, int rowEnd = MT) {
#pragma unroll 1
    for (int row = gw; row < rowEnd; row += 2 * NGW) { const int row2 = row + NGW; const bool has2 = row2 < rowEnd; const int rB = has2 ? row2 : row;
        f32x4* xa = (f32x4*)(X + (size_t)row * DM) + lane; f32x4* xb = (f32x4*)(X + (size_t)rB * DM) + lane; f32x4 va[4], vb[4]; float sa = 0.f, sb = 0.f;
#pragma unroll
        for (int j = 0; j < 4; ++j) { va[j] = xa[64 * j]; vb[j] = xb[64 * j]; }
#pragma unroll
        for (int j = 0; j < 4; ++j) { sa += (va[j].x * va[j].x + va[j].y * va[j].y) + (va[j].z * va[j].z + va[j].w * va[j].w); sb += (vb[j].x * vb[j].x + vb[j].y * vb[j].y) + (vb[j].z * vb[j].z + vb[j].w * vb[j].w); }
#pragma unroll
        for (int o = 1; o < 64; o <<= 1) { sa += __shfl_xor(sa, o); sb += __shfl_xor(sb, o); }
        const float ra = rsqrtf(sa * (1.f / DM) + 1e-6f), rb = rsqrtf(sb * (1.f / DM) + 1e-6f);
#pragma unroll
        for (int j = 0; j < 4; ++j) { const f32x4 gv = *(const f32x4*)(g + 4 * lane + 256 * j); xa[64 * j] = va[j] * ra * gv; if (has2) xb[64 * j] = vb[j] * rb * gv; }
    }
}
__device__ __forceinline__ void sincos_acc(float a, float& s, float& c) {
    const double ad = (double)a; const double k = rint(ad * 0.63661977236758134308); const float r = (float)(ad - k * 1.57079632679489661923); const float r2 = r * r;
    const float sp = r * (1.f + r2 * (-1.6666666667e-1f + r2 * (8.3333333333e-3f + r2 * (-1.9841269841e-4f + r2 * 2.7557319224e-6f))));
    const float cp = 1.f + r2 * (-0.5f + r2 * (4.1666666667e-2f + r2 * (-1.3888888889e-3f + r2 * (2.4801587302e-5f + r2 * (-2.7557319224e-7f)))));
    const int q = ((int)k) & 3;
    s = (q == 0) ? sp : ((q == 1) ? cp : ((q == 2) ? -sp : -cp));
    c = (q == 0) ? cp : ((q == 1) ? -sp : ((q == 2) ? -cp : sp));
}
struct MixIn { unsigned q[3], kvw[2]; unsigned short x1, x2; int pos; u32x4 kc, kp; u32x2 lc, lp; };
__device__ __forceinline__ void mixprep_load(MixIn& m, const bf16* PM, const bf16* PR, const int* pos, int row, int lane) {
    const bf16* pm = PM + (size_t)row * 768; const int ri = lane & 31;
#pragma unroll
    for (int j = 0; j < 3; ++j) m.q[j] = *(const unsigned*)(pm + 2 * lane + 128 * j);
#pragma unroll
    for (int j = 0; j < 2; ++j) m.kvw[j] = *(const unsigned*)(pm + 384 + 2 * lane + 128 * j);
    m.x1 = pm[640 + ri]; m.x2 = pm[672 + ri]; m.pos = pos[row];
    const bool hp = (row & (SEQ - 1)) != 0; const size_t rp = hp ? (size_t)(row - 1) : (size_t)row;
    m.kc = *(const u32x4*)(PR + (size_t)row * 1792 + 512 + 8 * lane); m.kp = *(const u32x4*)(PR + rp * 1792 + 512 + 8 * lane);
    m.lc = *(const u32x2*)(PR + (size_t)row * 1792 + 1536 + 4 * lane); m.lp = *(const u32x2*)(PR + rp * 1792 + 1536 + 4 * lane);
    if (!hp) { m.kp = (u32x4){0u, 0u, 0u, 0u}; m.lp = (u32x2){0u, 0u}; }
}
__device__ __forceinline__ void mixprep_compute(const MixIn& m, const Args& a, int row, int lane, float invf) {
    unsigned char* ws = a.ws;
    bf16* QN = (bf16*)(ws + WS_QN); bf16* KVN = (bf16*)(ws + WS_KVN); bf16* KR = (bf16*)(ws + WS_KR); bf16* LIN = (bf16*)(ws + WS_LIN); float* CS = (float*)(ws + WS_CS);
    const float* qg = (const float*)a.in[11]; const float* kvg = (const float*)a.in[13]; const float* mix = (const float*)a.in[16] + 1536; const int ri = lane & 31;
    float q[6], kq[4]; float s = 0.f, s2 = 0.f;
#pragma unroll
    for (int j = 0; j < 3; ++j) { q[2 * j] = bf2f(m.q[j] & 0xffffu); q[2 * j + 1] = bf2f(m.q[j] >> 16); s += q[2 * j] * q[2 * j] + q[2 * j + 1] * q[2 * j + 1]; }
#pragma unroll
    for (int j = 0; j < 2; ++j) { kq[2 * j] = bf2f(m.kvw[j] & 0xffffu); kq[2 * j + 1] = bf2f(m.kvw[j] >> 16); s2 += kq[2 * j] * kq[2 * j] + kq[2 * j + 1] * kq[2 * j + 1]; }
    float kc[8], kp[8]; unpack8(m.kc, kc); unpack8(m.kp, kp);
    const float* mk = (const float*)a.in[16] + 512 + 8 * lane; const float* kkp = (const float*)a.in[22] + 8 * lane; float ss = 0.f;
#pragma unroll
    for (int e = 0; e < 8; ++e) { const float kx = (kc[e] + (kp[e] - kc[e]) * mk[e]) * kkp[e]; ss += kx * kx; }
#pragma unroll
    for (int o = 1; o < 64; o <<= 1) { s += __shfl_xor(s, o); s2 += __shfl_xor(s2, o); if (o < 8) ss += __shfl_xor(ss, o); }
    const float rinv = rsqrtf(s * (1.f / 384.f) + 1e-6f), rinv2 = rsqrtf(s2 * (1.f / 256.f) + 1e-6f);
#pragma unroll
    for (int j = 0; j < 3; ++j) { const int col = 2 * lane + 128 * j; *(unsigned*)(QN + (size_t)row * 384 + col) = pk2(q[2 * j] * rinv * qg[col], q[2 * j + 1] * rinv * qg[col + 1]); }
#pragma unroll
    for (int j = 0; j < 2; ++j) { const int col = 2 * lane + 128 * j; *(unsigned*)(KVN + (size_t)row * 256 + col) = pk2(kq[2 * j] * rinv2 * kvg[col], kq[2 * j + 1] * rinv2 * kvg[col + 1]); }
    if ((lane & 7) == 0) ((float*)(ws + WS_CT))[(size_t)row * 8 + (lane >> 3)] = 1.f / fmaxf(sqrtf(ss), 1e-12f);
    { const float ang = (float)m.pos * invf; float sn, cn; sincos_acc(ang, sn, cn);
      const float x1 = bf2f(m.x1), x2 = bf2f(m.x2);
      if (lane < 32) { CS[(size_t)row * 64 + ri] = cn; CS[(size_t)row * 64 + 32 + ri] = sn;
          const unsigned o = pk2(x1 * cn - x2 * sn, x2 * cn + x1 * sn);
          KR[(size_t)row * 64 + 8 * (ri >> 2) + (ri & 3)] = (bf16)(o & 0xffffu); KR[(size_t)row * 64 + 8 * (ri >> 2) + 4 + (ri & 3)] = (bf16)(o >> 16); } }
    { const f32x4 mx = *(const f32x4*)(mix + 4 * lane);
      float cu[4] = {bf2f(m.lc.x & 0xffffu), bf2f(m.lc.x >> 16), bf2f(m.lc.y & 0xffffu), bf2f(m.lc.y >> 16)}; const float pv[4] = {bf2f(m.lp.x & 0xffffu), bf2f(m.lp.x >> 16), bf2f(m.lp.y & 0xffffu), bf2f(m.lp.y >> 16)};
#pragma unroll
      for (int e = 0; e < 4; ++e) { float p = cu[e] + (pv[e] - cu[e]) * mx[e];
          if (lane < 16) p = 1.f - 2.f / (1.f + __expf(2.f * p)); else if (lane >= 32) p = 1.f / (1.f + __expf(-p));
          cu[e] = p; }
      u32x2 w; w.x = pk2(cu[0], cu[1]); w.y = pk2(cu[2], cu[3]); *(u32x2*)(LIN + (size_t)row * 256 + 4 * lane) = w; }
}
__device__ __forceinline__ void phase_mixprep(const Args& a, int lane, int gw, int NGW, int rowEnd = MT) {
    unsigned char* ws = a.ws;
    const bf16* PM = (const bf16*)(ws + WS_PMLA); const bf16* PR = (const bf16*)(ws + WS_PRW); const int* pos = (const int*)a.in[2];
    const float invf = powf(10000.0f, -(float)(lane & 31) / 32.0f);
#pragma unroll 1
    for (int row = gw; row < rowEnd; row += 2 * NGW) { const int row2 = row + NGW; const bool has2 = row2 < rowEnd;
        MixIn A, B; mixprep_load(A, PM, PR, pos, row, lane); mixprep_load(B, PM, PR, pos, has2 ? row2 : row, lane);
        mixprep_compute(A, a, row, lane, invf); if (has2) mixprep_compute(B, a, row2, lane, invf); }
}
__device__ __forceinline__ void phase_yanorm(bf16* YC, const float* g, int lane, int gw, int NGW) {
    for (int row = gw; row < MT; row += NGW) { u32x4* p = (u32x4*)(YC + (size_t)row * DM + 8 * lane); float f[8]; unpack8(*p, f); float s = 0.f;
#pragma unroll
        for (int e = 0; e < 8; ++e) s += f[e] * f[e];
        const float rinv = rsqrtf(wave_sum(s) * (1.f / 512.f) + 1e-6f); const f32x4 g0 = *(const f32x4*)(g + 8 * lane), g1 = *(const f32x4*)(g + 8 * lane + 4);
        u32x4 o; o.x = pk2(f[0] * rinv * g0.x, f[1] * rinv * g0.y); o.y = pk2(f[2] * rinv * g0.z, f[3] * rinv * g0.w); o.z = pk2(f[4] * rinv * g1.x, f[5] * rinv * g1.y); o.w = pk2(f[6] * rinv * g1.z, f[7] * rinv * g1.w); *p = o; }
}

constexpr int AT_KSTR = 400, AT_VSTR = 144, AT_KB = 64 * AT_KSTR, AT_VB = 128 * AT_VSTR, AT_STAGE = AT_KB + AT_VB;
__device__ __forceinline__ void attn_unit(const bf16* QB, const bf16* KN, const bf16* KR, const bf16* VT, bf16* YC, LAS unsigned char* lds, int b, int h, int u, int tid, int lane, int wave) {
    const int r32 = lane & 31, hi = lane >> 5;
    const int q0 = u * 256 + wave * 32; const size_t tokq = (size_t)b * SEQ + q0 + r32;
    const int nt_unit = 4 * u + 4, nt_wave = 4 * u + (wave >> 1) + 1;
    bf16x8 qf[12];
#pragma unroll
    for (int ks = 0; ks < 12; ++ks) qf[ks] = *(const bf16x8*)(QB + tokq * 768 + h * 192 + 16 * ks + 8 * hi);
    f32x16 ot[4];
#pragma unroll
    for (int d = 0; d < 4; ++d)
#pragma unroll
        for (int i = 0; i < 16; ++i) ot[d][i] = 0.f;
    float m_run = -INFINITY, l_run = 0.f;
    unsigned knoff[2], vtoff[2]; int kndst[2], vtdst[2];
#pragma unroll
    for (int i = 0; i < 2; ++i) { const int c = tid + 512 * i; { const int row = c >> 4, cc = c & 15; knoff[i] = (unsigned)((b * SEQ + row) * 512 + h * 128 + cc * 8); kndst[i] = row * AT_KSTR + cc * 16; }
        { const int row = c >> 3, cc = c & 7; vtoff[i] = (unsigned)((h * 128 + row) * MT + b * SEQ + cc * 8); vtdst[i] = AT_KB + row * AT_VSTR + cc * 16; } }
    const unsigned kroff = (unsigned)((b * SEQ + (tid >> 3)) * 64 + (tid & 7) * 8); const int krdst = (tid >> 3) * AT_KSTR + 256 + (tid & 7) * 16;
    u32x4 kreg[3], vreg[2];
#pragma unroll
    for (int i = 0; i < 2; ++i) { kreg[i] = *(const u32x4*)(KN + knoff[i]); vreg[i] = *(const u32x4*)(VT + vtoff[i]); }
    kreg[2] = *(const u32x4*)(KR + kroff);
    __syncthreads();
#pragma unroll
    for (int i = 0; i < 2; ++i) { *(LAS u32x4*)(lds + kndst[i]) = kreg[i]; *(LAS u32x4*)(lds + vtdst[i]) = vreg[i]; }
    *(LAS u32x4*)(lds + krdst) = kreg[2];
    if (nt_unit > 1) {
#pragma unroll
        for (int i = 0; i < 2; ++i) { kreg[i] = *(const u32x4*)(KN + (knoff[i] + 64u * 512u)); vreg[i] = *(const u32x4*)(VT + (vtoff[i] + 64u)); }
        kreg[2] = *(const u32x4*)(KR + (kroff + 64u * 64u)); }
    __syncthreads();
    for (int kt = 0; kt < nt_unit; ++kt) {
        if (kt + 1 < nt_unit) { LAS unsigned char* nx = lds + ((kt + 1) & 1) * AT_STAGE;
#pragma unroll
            for (int i = 0; i < 2; ++i) { *(LAS u32x4*)(nx + kndst[i]) = kreg[i]; *(LAS u32x4*)(nx + vtdst[i]) = vreg[i]; }
            *(LAS u32x4*)(nx + krdst) = kreg[2];
            if (kt + 2 < nt_unit) { const unsigned t2 = (unsigned)(kt + 2) * 64u;
#pragma unroll
                for (int i = 0; i < 2; ++i) { kreg[i] = *(const u32x4*)(KN + (knoff[i] + t2 * 512u)); vreg[i] = *(const u32x4*)(VT + (vtoff[i] + t2)); }
                kreg[2] = *(const u32x4*)(KR + (kroff + t2 * 64u)); }
        }
        LAS unsigned char* st = lds + (kt & 1) * AT_STAGE;
        if (kt < nt_wave) {
            f32x16 sa[2];
#pragma unroll
            for (int mt = 0; mt < 2; ++mt) {
#pragma unroll
                for (int i = 0; i < 16; ++i) sa[mt][i] = 0.f;
#pragma unroll
                for (int ks = 0; ks < 12; ++ks) { const bf16x8 af = *(const LAS bf16x8*)(st + (32 * mt + r32) * AT_KSTR + 32 * ks + 16 * hi);
                    sa[mt] = __builtin_amdgcn_mfma_f32_32x32x16_bf16(af, qf[ks], sa[mt], 0, 0, 0); }
            }
            float mx = sa[0][0];
#pragma unroll
            for (int i = 1; i < 16; ++i) mx = fmaxf(mx, sa[0][i]);
#pragma unroll
            for (int i = 0; i < 16; ++i) mx = fmaxf(mx, sa[1][i]);
            mx = fmaxf(mx, __shfl_xor(mx, 32));
            const bool grow = __builtin_amdgcn_ballot_w64(mx - m_run > 8.0f) != 0ull;
            const float m_new = grow ? fmaxf(m_run, mx) : m_run; const float alpha = grow ? __builtin_amdgcn_exp2f(m_run - m_new) : 1.0f; m_run = m_new;
            float ls = 0.f;
#pragma unroll
            for (int mt = 0; mt < 2; ++mt)
#pragma unroll
                for (int i = 0; i < 16; ++i) { const float p = __builtin_amdgcn_exp2f(sa[mt][i] - m_new); sa[mt][i] = p; ls += p; }
            l_run = l_run * alpha + ls;
            if (grow) {
#pragma unroll
                for (int d = 0; d < 4; ++d)
#pragma unroll
                    for (int i = 0; i < 16; ++i) ot[d][i] *= alpha;
            }
#pragma unroll
            for (int mt = 0; mt < 2; ++mt)
#pragma unroll
                for (int s = 0; s < 2; ++s) { u32x4 w; w.x = pk2(sa[mt][8 * s + 0], sa[mt][8 * s + 1]); w.y = pk2(sa[mt][8 * s + 2], sa[mt][8 * s + 3]); w.z = pk2(sa[mt][8 * s + 4], sa[mt][8 * s + 5]); w.w = pk2(sa[mt][8 * s + 6], sa[mt][8 * s + 7]);
                    const bf16x8 pf = __builtin_bit_cast(bf16x8, w);
#pragma unroll
                    for (int d = 0; d < 4; ++d) { const bf16x8 vf = *(const LAS bf16x8*)(st + AT_KB + (32 * d + r32) * AT_VSTR + 64 * mt + 32 * s + 16 * hi);
                        ot[d] = __builtin_amdgcn_mfma_f32_32x32x16_bf16(vf, pf, ot[d], 0, 0, 0); } }
        }
        __syncthreads();
    }
    const float linv = 1.f / (l_run + __shfl_xor(l_run, 32));
    bf16* orow = YC + tokq * DM + h * 128;
#pragma unroll
    for (int d = 0; d < 4; ++d)
#pragma unroll
        for (int g = 0; g < 4; ++g) { u32x2 w; w.x = pk2(ot[d][4 * g] * linv, ot[d][4 * g + 1] * linv); w.y = pk2(ot[d][4 * g + 2] * linv, ot[d][4 * g + 3] * linv); *(u32x2*)(orow + 32 * d + 8 * g + 4 * hi) = w; }
}
constexpr int RW_BLK = 8, RW_VEC = 6 * 64, RW_LDS_WAVE = RW_BLK * RW_VEC * 4;
__device__ __forceinline__ void rw_shift8(const bf16* PR, const float* mix, size_t tok, int s, int col, float* cur) {
    float prv[8]; unpack8(*(const u32x4*)(PR + tok * 1792 + col), cur);
    u32x4 pw = {0u, 0u, 0u, 0u}; if (s > 0) pw = *(const u32x4*)(PR + (tok - 1) * 1792 + col); unpack8(pw, prv);
    const f32x4 m0 = *(const f32x4*)(mix + col), m1 = *(const f32x4*)(mix + col + 4);
#pragma unroll
    for (int e = 0; e < 4; ++e) { cur[e] += (prv[e] - cur[e]) * m0[e]; cur[e + 4] += (prv[e + 4] - cur[e + 4]) * m1[e]; }
}
__device__ __forceinline__ void rw_prep(const Args& a, LAS float* blk, int b, int h, int s0, int lane) {
    unsigned char* ws = a.ws;
    const bf16* PR = (const bf16*)(ws + WS_PRW); const float* DEC = (const float*)(ws + WS_DEC); const bf16* AL = (const bf16*)(ws + WS_AL);
    const float* mix = (const float*)a.in[16]; const float* k_k = (const float*)a.in[22]; const float* k_a = (const float*)a.in[23];
    const int tt = lane >> 3, k0 = 8 * (lane & 7), ch = h * 64 + k0; const int s = s0 + tt; const size_t tok = (size_t)b * SEQ + s;
    LAS float* o = blk + tt * RW_VEC + k0;
    { float r[8]; rw_shift8(PR, mix, tok, s, ch, r); *(LAS f32x4*)(o + 256) = (f32x4){r[0], r[1], r[2], r[3]}; *(LAS f32x4*)(o + 260) = (f32x4){r[4], r[5], r[6], r[7]}; }
    __builtin_amdgcn_sched_barrier(0);
    { float r[8]; rw_shift8(PR, mix, tok, s, 1024 + ch, r); *(LAS f32x4*)(o + 320) = (f32x4){r[0], r[1], r[2], r[3]}; *(LAS f32x4*)(o + 324) = (f32x4){r[4], r[5], r[6], r[7]}; }
    __builtin_amdgcn_sched_barrier(0);
    { const f32x4 d0 = *(const f32x4*)(DEC + tok * 512 + ch), d1 = *(const f32x4*)(DEC + tok * 512 + ch + 4); *(LAS f32x4*)(o) = d0; *(LAS f32x4*)(o + 4) = d1; }
    __builtin_amdgcn_sched_barrier(0);
    float kc[8]; rw_shift8(PR, mix, tok, s, 512 + ch, kc);
    float al[8]; unpack8(*(const u32x4*)(AL + tok * 512 + ch), al);
    const f32x4 kk0 = *(const f32x4*)(k_k + ch), kk1 = *(const f32x4*)(k_k + ch + 4), ka0 = *(const f32x4*)(k_a + ch), ka1 = *(const f32x4*)(k_a + ch + 4);
    float kk[8], ss = 0.f;
#pragma unroll
    for (int e = 0; e < 8; ++e) { kk[e] = kc[e] * (e < 4 ? kk0[e & 3] : kk1[e & 3]); ss += kk[e] * kk[e]; }
    ss += __shfl_xor(ss, 1); ss += __shfl_xor(ss, 2); ss += __shfl_xor(ss, 4);
    const float rn = 1.f / fmaxf(sqrtf(ss), 1e-12f);
    f32x4 t0, t1;
#pragma unroll
    for (int e = 0; e < 4; ++e) { t0[e] = kk[e] * rn; t1[e] = kk[e + 4] * rn; }
    *(LAS f32x4*)(o + 64) = t0; *(LAS f32x4*)(o + 68) = t1;
#pragma unroll
    for (int e = 0; e < 4; ++e) { t0[e] *= al[e]; t1[e] *= al[e + 4]; }
    *(LAS f32x4*)(o + 128) = t0; *(LAS f32x4*)(o + 132) = t1;
#pragma unroll
    for (int e = 0; e < 4; ++e) { t0[e] = kc[e] * (1.f + (al[e] - 1.f) * ka0[e]); t1[e] = kc[e + 4] * (1.f + (al[e + 4] - 1.f) * ka1[e]); }
    *(LAS f32x4*)(o + 192) = t0; *(LAS f32x4*)(o + 196) = t1;
}
#define RW_LDS_FENCE() do { asm volatile("s_waitcnt lgkmcnt(0)" ::: "memory"); __builtin_amdgcn_wave_barrier(); } while (0)
template <bool IDENT>
__device__ __forceinline__ void rw_pass1(const Args& a, LAS float* blk, int item, int lane) {
    const int bh = item / RW_NC, c = item % RW_NC, b = bh >> 3, h = bh & 7;
    float sV[64];
#pragma unroll
    for (int k = 0; k < 64; ++k) sV[k] = (IDENT && k == lane) ? 1.f : 0.f;
    for (int blkI = 0; blkI < RW_T / RW_BLK; ++blkI) {
        RW_LDS_FENCE();
        rw_prep(a, blk, b, h, c * RW_T + blkI * RW_BLK, lane);
        RW_LDS_FENCE();
#pragma unroll 1
        for (int tt = 0; tt < RW_BLK; ++tt) { const LAS float* vb = blk + tt * RW_VEC;
            float dV = 0.f;
#pragma unroll
            for (int k4 = 0; k4 < 16; ++k4) { const f32x4 kk = *(const LAS f32x4*)(vb + 64 + 4 * k4);
#pragma unroll
                for (int e = 0; e < 4; ++e) dV += sV[4 * k4 + e] * kk[e]; }
            const float vv = IDENT ? 0.f : vb[320 + lane];
#pragma unroll
            for (int k4 = 0; k4 < 16; ++k4) { const f32x4 w = *(const LAS f32x4*)(vb + 4 * k4), bb = *(const LAS f32x4*)(vb + 128 + 4 * k4);
                if (IDENT) {
#pragma unroll
                    for (int e = 0; e < 4; ++e) sV[4 * k4 + e] = sV[4 * k4 + e] * w[e] - dV * bb[e];
                } else { const f32x4 kv = *(const LAS f32x4*)(vb + 192 + 4 * k4);
#pragma unroll
                    for (int e = 0; e < 4; ++e) sV[4 * k4 + e] = sV[4 * k4 + e] * w[e] + (vv * kv[e] - dV * bb[e]); } }
        }
    }
    float* O = (float*)(a.ws + (IDENT ? WS_G : WS_J)) + ((size_t)item * 64 + lane) * 64;
#pragma unroll
    for (int k4 = 0; k4 < 16; ++k4) *(f32x4*)(O + 4 * k4) = (f32x4){sV[4 * k4], sV[4 * k4 + 1], sV[4 * k4 + 2], sV[4 * k4 + 3]};
}
__device__ __forceinline__ void rw_pass3(const Args& a, LAS float* blk, int item, int lane) {
    const int bh = item / RW_NC, c = item % RW_NC, b = bh >> 3, h = bh & 7, ch = h * 64 + lane;
    float sV[64];
    { const float* S0 = (const float*)(a.ws + WS_SST) + ((size_t)item * 64 + lane) * 64;
#pragma unroll
      for (int k4 = 0; k4 < 16; ++k4) { const f32x4 t = *(const f32x4*)(S0 + 4 * k4); sV[4 * k4] = t.x; sV[4 * k4 + 1] = t.y; sV[4 * k4 + 2] = t.z; sV[4 * k4 + 3] = t.w; } }
    const float rk = ((const float*)a.in[24])[ch], lnw = ((const float*)a.in[25])[ch], lnb = ((const float*)a.in[26])[ch];
    bf16* YC = (bf16*)(a.ws + WS_U);
    for (int blkI = 0; blkI < RW_T / RW_BLK; ++blkI) {
        RW_LDS_FENCE();
        rw_prep(a, blk, b, h, c * RW_T + blkI * RW_BLK, lane);
        RW_LDS_FENCE();
#pragma unroll 1
        for (int tt = 0; tt < RW_BLK; ++tt) { const LAS float* vb = blk + tt * RW_VEC;
            float dV = 0.f;
#pragma unroll
            for (int k4 = 0; k4 < 16; ++k4) { const f32x4 kk = *(const LAS f32x4*)(vb + 64 + 4 * k4);
#pragma unroll
                for (int e = 0; e < 4; ++e) dV += sV[4 * k4 + e] * kk[e]; }
            const float vv = vb[320 + lane]; float y = 0.f;
#pragma unroll
            for (int k4 = 0; k4 < 16; ++k4) { const f32x4 w = *(const LAS f32x4*)(vb + 4 * k4), bb = *(const LAS f32x4*)(vb + 128 + 4 * k4), kv = *(const LAS f32x4*)(vb + 192 + 4 * k4), r = *(const LAS f32x4*)(vb + 256 + 4 * k4);
#pragma unroll
                for (int e = 0; e < 4; ++e) { const float sn = sV[4 * k4 + e] * w[e] + (vv * kv[e] - dV * bb[e]); sV[4 * k4 + e] = sn; y += sn * r[e]; } }
            float s1 = y, s2 = y * y, s3 = vb[256 + lane] * vb[192 + lane] * rk;
#pragma unroll
            for (int o = 1; o < 64; o <<= 1) { s1 += __shfl_xor(s1, o); s2 += __shfl_xor(s2, o); s3 += __shfl_xor(s3, o); }
            const float mean = s1 * (1.f / 64.f), var = fmaxf(s2 * (1.f / 64.f) - mean * mean, 0.f);
            const float yn = (y - mean) * rsqrtf(var + 64e-5f) * lnw + lnb;
            bf16* gp = YC + ((size_t)b * SEQ + c * RW_T + blkI * RW_BLK + tt) * DM + 512 + ch;
            const float g = bf2f(*gp);
            *gp = (bf16)(pk2((yn + s3 * vv) * g, 0.f) & 0xffffu);
        }
    }
}
__device__ __forceinline__ void rw_scan(const Args& a, LAS unsigned char* lds, int bh, int tid) {
    LAS float* Sb = (LAS float*)lds; LAS float* Gb = (LAS float*)(lds + 64 * 68 * 4);
    const int v = tid >> 3, k0 = 8 * (tid & 7);
    const float* G = (const float*)(a.ws + WS_G) + (size_t)bh * RW_NC * 4096; const float* J = (const float*)(a.ws + WS_J) + (size_t)bh * RW_NC * 4096; float* SST = (float*)(a.ws + WS_SST) + (size_t)bh * RW_NC * 4096;
    f32x4 s0 = {0.f, 0.f, 0.f, 0.f}, s1 = s0;
    f32x4 g0 = *(const f32x4*)(G + tid * 8), g1 = *(const f32x4*)(G + tid * 8 + 4), j0 = *(const f32x4*)(J + v * 64 + k0), j1 = *(const f32x4*)(J + v * 64 + k0 + 4);
    for (int c = 0; c < RW_NC; ++c) {
        *(f32x4*)(SST + (size_t)c * 4096 + v * 64 + k0) = s0; *(f32x4*)(SST + (size_t)c * 4096 + v * 64 + k0 + 4) = s1;
        if (c == RW_NC - 1) break;
        *(LAS f32x4*)(Sb + v * 68 + k0) = s0; *(LAS f32x4*)(Sb + v * 68 + k0 + 4) = s1;
        *(LAS f32x4*)(Gb + tid * 8) = g0; *(LAS f32x4*)(Gb + tid * 8 + 4) = g1;
        f32x4 a0 = j0, a1 = j1;
        __syncthreads();
        if (c + 1 < RW_NC - 1) { const size_t o = (size_t)(c + 1) * 4096; g0 = *(const f32x4*)(G + o + tid * 8); g1 = *(const f32x4*)(G + o + tid * 8 + 4); j0 = *(const f32x4*)(J + o + v * 64 + k0); j1 = *(const f32x4*)(J + o + v * 64 + k0 + 4); }
#pragma unroll 4
        for (int i4 = 0; i4 < 16; ++i4) { const f32x4 sv = *(const LAS f32x4*)(Sb + v * 68 + 4 * i4);
#pragma unroll
            for (int e = 0; e < 4; ++e) { const f32x4 ga = *(const LAS f32x4*)(Gb + (4 * i4 + e) * 64 + k0), gb = *(const LAS f32x4*)(Gb + (4 * i4 + e) * 64 + k0 + 4); a0 += ga * sv[e]; a1 += gb * sv[e]; } }
        s0 = a0; s1 = a1;
        __syncthreads();
    }
}

constexpr int SQ_BLK = 16, SQ_VEC = 392, SQ_BUF = SQ_BLK * SQ_VEC * 4, SQ_YOFF = 2 * SQ_BUF, SQ_YBUF = SQ_BLK * 64 * 8, SQ_NBLK = SEQ / SQ_BLK;
__device__ __forceinline__ float dpp_f(float v, const int ctrl) { return v; }
#define DPPF(v, ctrl) __builtin_bit_cast(float, __builtin_amdgcn_update_dpp(0, __builtin_bit_cast(int, (v)), (ctrl), 0xF, 0xF, true))
__device__ __forceinline__ float red8(float v) { v += DPPF(v, 0xB1); v += DPPF(v, 0x4E); v += DPPF(v, 0x141); return v; }
__device__ __forceinline__ void rw_seq(const Args& a, LAS unsigned char* lds, int bh, int tid, bool do_store) {
    const int b = bh >> 3, h = bh & 7, wave = __builtin_amdgcn_readfirstlane(tid >> 6), lane = tid & 63;
    unsigned char* ws = a.ws;
    if (wave >= 4) {
        const int tp = tid - 256, tt = tp >> 4, kq = tp & 15, k0 = 4 * kq, ch = h * 64 + k0;
        const bf16* PR = (const bf16*)(ws + WS_PRW); const float* DEC = (const float*)(ws + WS_DEC); const bf16* AL = (const bf16*)(ws + WS_AL); bf16* YC = (bf16*)(ws + WS_U);
        const float* mixp = (const float*)a.in[16];
        const f32x4 mx0 = *(const f32x4*)(mixp + ch), mx1 = *(const f32x4*)(mixp + 512 + ch), mx2 = *(const f32x4*)(mixp + 1024 + ch);
        const f32x4 kkc = *(const f32x4*)((const float*)a.in[22] + ch), kac = *(const f32x4*)((const float*)a.in[23] + ch), rkc = *(const f32x4*)((const float*)a.in[24] + ch);
        const f32x4 lnw = *(const f32x4*)((const float*)a.in[25] + ch), lnb = *(const f32x4*)((const float*)a.in[26] + ch);
        u32x2 cur[3], prv[3], alr; f32x4 dcr; u32x2 cur2[3], prv2[3], alr2; f32x4 dcr2; u32x2 gq = {0u, 0u};
        { const size_t tok = (size_t)b * SEQ + tt;
#pragma unroll
          for (int j = 0; j < 3; ++j) { cur[j] = *(const u32x2*)(PR + tok * 1792 + 512 * j + ch); prv[j] = (u32x2){0u, 0u}; if (tt > 0) prv[j] = *(const u32x2*)(PR + (tok - 1) * 1792 + 512 * j + ch); }
          alr = *(const u32x2*)(AL + tok * 512 + ch); dcr = *(const f32x4*)(DEC + tok * 512 + ch); }
        { const size_t tok = (size_t)b * SEQ + SQ_BLK + tt;
#pragma unroll
          for (int j = 0; j < 3; ++j) { cur2[j] = *(const u32x2*)(PR + tok * 1792 + 512 * j + ch); prv2[j] = *(const u32x2*)(PR + (tok - 1) * 1792 + 512 * j + ch); }
          alr2 = *(const u32x2*)(AL + tok * 512 + ch); dcr2 = *(const f32x4*)(DEC + tok * 512 + ch); }
        for (int n = 0; n <= SQ_NBLK + 1; ++n) {
            if (n < SQ_NBLK) {
                LAS float* o = (LAS float*)(lds + (n & 1) * SQ_BUF) + tt * SQ_VEC + k0;
                f32x4 r4, k4, v4, al4;
                { const f32x4 c0 = {bf2f(cur[0].x & 0xffffu), bf2f(cur[0].x >> 16), bf2f(cur[0].y & 0xffffu), bf2f(cur[0].y >> 16)}, p0 = {bf2f(prv[0].x & 0xffffu), bf2f(prv[0].x >> 16), bf2f(prv[0].y & 0xffffu), bf2f(prv[0].y >> 16)}; r4 = c0 + (p0 - c0) * mx0; }
                { const f32x4 c0 = {bf2f(cur[1].x & 0xffffu), bf2f(cur[1].x >> 16), bf2f(cur[1].y & 0xffffu), bf2f(cur[1].y >> 16)}, p0 = {bf2f(prv[1].x & 0xffffu), bf2f(prv[1].x >> 16), bf2f(prv[1].y & 0xffffu), bf2f(prv[1].y >> 16)}; k4 = c0 + (p0 - c0) * mx1; }
                { const f32x4 c0 = {bf2f(cur[2].x & 0xffffu), bf2f(cur[2].x >> 16), bf2f(cur[2].y & 0xffffu), bf2f(cur[2].y >> 16)}, p0 = {bf2f(prv[2].x & 0xffffu), bf2f(prv[2].x >> 16), bf2f(prv[2].y & 0xffffu), bf2f(prv[2].y >> 16)}; v4 = c0 + (p0 - c0) * mx2; }
                al4 = (f32x4){bf2f(alr.x & 0xffffu), bf2f(alr.x >> 16), bf2f(alr.y & 0xffffu), bf2f(alr.y >> 16)};
                f32x4 kk = k4 * kkc; float ss = (kk.x * kk.x + kk.y * kk.y) + (kk.z * kk.z + kk.w * kk.w);
                ss += __shfl_xor(ss, 1); ss += __shfl_xor(ss, 2); ss += __shfl_xor(ss, 4); ss += __shfl_xor(ss, 8);
                const float rn = 1.f / fmaxf(sqrtf(ss), 1e-12f); kk = kk * rn;
                const f32x4 kv = k4 * ((al4 - 1.f) * kac + 1.f);
                const f32x4 cp = r4 * kv * rkc; float cs = (cp.x + cp.y) + (cp.z + cp.w);
                cs += __shfl_xor(cs, 1); cs += __shfl_xor(cs, 2); cs += __shfl_xor(cs, 4); cs += __shfl_xor(cs, 8);
                *(LAS f32x4*)(o) = dcr; *(LAS f32x4*)(o + 64) = kk; *(LAS f32x4*)(o + 128) = kk * al4; *(LAS f32x4*)(o + 192) = kv; *(LAS f32x4*)(o + 256) = r4; *(LAS f32x4*)(o + 320) = v4;
                if (kq == 0) o[384] = cs;
            }
#pragma unroll
            for (int j = 0; j < 3; ++j) { cur[j] = cur2[j]; prv[j] = prv2[j]; }
            alr = alr2; dcr = dcr2;
            if (n + 2 < SQ_NBLK) { const size_t tok = (size_t)b * SEQ + (n + 2) * SQ_BLK + tt;
#pragma unroll
                for (int j = 0; j < 3; ++j) { cur2[j] = *(const u32x2*)(PR + tok * 1792 + 512 * j + ch); prv2[j] = *(const u32x2*)(PR + (tok - 1) * 1792 + 512 * j + ch); }
                alr2 = *(const u32x2*)(AL + tok * 512 + ch); dcr2 = *(const f32x4*)(DEC + tok * 512 + ch); }
            if (n >= 2) {
                const LAS f32x4* yb = (const LAS f32x4*)(lds + SQ_YOFF + (n & 1) * SQ_YBUF) + (tt * 64 + k0) / 2;
                const f32x4 y01 = yb[0], y23 = yb[1];
                float s1 = (y01.x + y01.z) + (y23.x + y23.z), s2 = (y01.x * y01.x + y01.z * y01.z) + (y23.x * y23.x + y23.z * y23.z);
#pragma unroll
                for (int o = 1; o < 16; o <<= 1) { s1 += __shfl_xor(s1, o); s2 += __shfl_xor(s2, o); }
                const float mean = s1 * (1.f / 64.f), var = fmaxf(s2 * (1.f / 64.f) - mean * mean, 0.f), rstd = rsqrtf(var + 64e-5f);
                bf16* gp = YC + ((size_t)b * SEQ + (n - 2) * SQ_BLK + tt) * DM + 512 + ch;
                const u32x2 gw = gq;
                const float o0 = (((y01.x - mean) * rstd) * lnw.x + lnb.x + y01.y) * bf2f(gw.x & 0xffffu), o1 = (((y01.z - mean) * rstd) * lnw.y + lnb.y + y01.w) * bf2f(gw.x >> 16);
                const float o2 = (((y23.x - mean) * rstd) * lnw.z + lnb.z + y23.y) * bf2f(gw.y & 0xffffu), o3 = (((y23.z - mean) * rstd) * lnw.w + lnb.w + y23.w) * bf2f(gw.y >> 16);
                u32x2 w; w.x = pk2(o0, o1); w.y = pk2(o2, o3); if (do_store) *(u32x2*)gp = w;
            }
            if (n >= 1 && n <= SQ_NBLK) gq = *(const u32x2*)(YC + ((size_t)b * SEQ + (n - 1) * SQ_BLK + tt) * DM + 512 + ch);
            __syncthreads();
        }
    } else {
        const int rg = lane >> 3, kq = lane & 7, r0 = 16 * wave + 2 * rg;
        f32x2 s0[4], s1[4];
#pragma unroll
        for (int i = 0; i < 4; ++i) { s0[i] = (f32x2){0.f, 0.f}; s1[i] = (f32x2){0.f, 0.f}; }
        for (int n = 0; n <= SQ_NBLK + 1; ++n) {
            if (n >= 1 && n <= SQ_NBLK) {
                const LAS float* vbase = (const LAS float*)(lds + ((n - 1) & 1) * SQ_BUF) + 8 * kq;
                LAS f32x4* yb = (LAS f32x4*)(lds + SQ_YOFF + ((n - 1) & 1) * SQ_YBUF) + r0 / 2;
#define SQ_LOAD(P, tt_) do { const LAS float* vb_ = vbase + (tt_) * SQ_VEC; P##ka = *(const LAS f32x4*)(vb_ + 64); P##kb = *(const LAS f32x4*)(vb_ + 68); P##wa = *(const LAS f32x4*)(vb_); P##wb = *(const LAS f32x4*)(vb_ + 4); \
        P##ba = *(const LAS f32x4*)(vb_ + 128); P##bb = *(const LAS f32x4*)(vb_ + 132); P##va = *(const LAS f32x4*)(vb_ + 192); P##vbv = *(const LAS f32x4*)(vb_ + 196); P##ra = *(const LAS f32x4*)(vb_ + 256); P##rb = *(const LAS f32x4*)(vb_ + 260); \
        P##vv = *(const LAS f32x2*)(vb_ - 8 * kq + 320 + r0); P##ct = vb_[384 - 8 * kq]; } while (0)
#define SQ_STEP(P, tt_) do { \
        const f32x2 kk[4] = {{P##ka.x, P##ka.y}, {P##ka.z, P##ka.w}, {P##kb.x, P##kb.y}, {P##kb.z, P##kb.w}}, ww[4] = {{P##wa.x, P##wa.y}, {P##wa.z, P##wa.w}, {P##wb.x, P##wb.y}, {P##wb.z, P##wb.w}}; \
        const f32x2 bq[4] = {{P##ba.x, P##ba.y}, {P##ba.z, P##ba.w}, {P##bb.x, P##bb.y}, {P##bb.z, P##bb.w}}, kv[4] = {{P##va.x, P##va.y}, {P##va.z, P##va.w}, {P##vbv.x, P##vbv.y}, {P##vbv.z, P##vbv.w}}; \
        const f32x2 rr[4] = {{P##ra.x, P##ra.y}, {P##ra.z, P##ra.w}, {P##rb.x, P##rb.y}, {P##rb.z, P##rb.w}}; \
        const f32x2 d0 = (s0[0] * kk[0] + s0[1] * kk[1]) + (s0[2] * kk[2] + s0[3] * kk[3]), d1 = (s1[0] * kk[0] + s1[1] * kk[1]) + (s1[2] * kk[2] + s1[3] * kk[3]); \
        f32x2 t0[4], t1[4]; \
        _Pragma("unroll") for (int i = 0; i < 4; ++i) { t0[i] = kv[i] * P##vv.x; t1[i] = kv[i] * P##vv.y; s0[i] = s0[i] * ww[i]; s1[i] = s1[i] * ww[i]; } \
        const float sa0 = -red8(d0.x + d0.y), sa1 = -red8(d1.x + d1.y); \
        f32x2 y0 = {0.f, 0.f}, y1 = {0.f, 0.f}; \
        _Pragma("unroll") for (int i = 0; i < 4; ++i) { s0[i] += t0[i] + bq[i] * sa0; s1[i] += t1[i] + bq[i] * sa1; y0 += s0[i] * rr[i]; y1 += s1[i] * rr[i]; } \
        const float ya = red8(y0.x + y0.y), yb1 = red8(y1.x + y1.y); \
        if (kq == 0) yb[(tt_) * 32] = (f32x4){ya, P##ct * P##vv.x, yb1, P##ct * P##vv.y}; } while (0)
                f32x4 Aka, Akb, Awa, Awb, Aba, Abb, Ava, Avbv, Ara, Arb, Bka, Bkb, Bwa, Bwb, Bba, Bbb, Bva, Bvbv, Bra, Brb; f32x2 Avv, Bvv; float Act, Bct;
                SQ_LOAD(A, 0);
#pragma unroll 1
                for (int tt = 0; tt < SQ_BLK; tt += 2) {
                    SQ_LOAD(B, tt + 1);
                    SQ_STEP(A, tt);
                    if (tt + 2 < SQ_BLK) SQ_LOAD(A, tt + 2);
                    SQ_STEP(B, tt + 1);
                }
            }
            __syncthreads();
        }
    }
}
constexpr int WY_T = 16, WY_NCH = SEQ / WY_T, WY_NP = 6;
constexpr int WY_AZ = 0, WY_AY1 = 2048, WY_AU = 4096, WY_AY2 = 5120, WY_AS = 6144, WY_VT = 10240, WY_PT = 12288, WY_SCR = 12544, WY_SLOT = 12544 + 5120, WY_FLAGS = WY_NP * WY_SLOT;
__device__ __forceinline__ int wy_perm_off(int t, int k) { const int n = k >> 4; return (n >> 1) * 1024 + t * 64 + ((k >> 2) & 3) * 16 + ((n & 1) * 4 + (k & 3)) * 2; }
__device__ __forceinline__ float red64(float v) { v += DPPF(v, 0xB1); v += DPPF(v, 0x4E); v += DPPF(v, 0x141); v += DPPF(v, 0x140); v += __shfl_xor(v, 16); v += __shfl_xor(v, 32); return v; }
__device__ __forceinline__ unsigned short bf1(float x) { return (unsigned short)(pk2(x, 0.f) & 0xffffu); }
#define WY_FENCE() do { asm volatile("s_waitcnt lgkmcnt(0)" ::: "memory"); __builtin_amdgcn_wave_barrier(); } while (0)
constexpr int WY_STGSZ = 6528, WY_STG = WY_NP * WY_SLOT + 64;
__device__ __forceinline__ void wy_issue(const Args& a, LAS unsigned char* stg, int b, int h, int c, int lane, float (&dec)[WY_T], float (&al)[WY_T], float (&rn)[WY_T]) {
    unsigned char* ws = a.ws;
    const bf16* PR = (const bf16*)(ws + WS_PRW); const float* DEC = (const float*)(ws + WS_DEC); const bf16* AL = (const bf16*)(ws + WS_AL); const float* CT = (const float*)(ws + WS_CT);
    const size_t tok0 = (size_t)b * SEQ + (size_t)c * WY_T; const int ch = h * 64 + lane;
#pragma unroll
    for (int j = 0; j < 7; ++j) { const int idx = j * 64 + lane;
        if (idx < 408) { const int row = idx >> 3, trel = row / 3, vec = row - 3 * trel; size_t tk = tok0 + trel; tk = (tk == 0) ? 1 : tk;
            __builtin_amdgcn_global_load_lds((const unsigned*)(PR + (tk - 1) * 1792 + vec * 512 + h * 64 + (idx & 7) * 8), (LAS unsigned*)(stg + j * 1024), 16, 0, 0); } }
#pragma unroll
    for (int t = 0; t < WY_T; ++t) { dec[t] = DEC[(tok0 + t) * 512 + ch]; al[t] = bf2f(AL[(tok0 + t) * 512 + ch]); rn[t] = CT[(tok0 + t) * 8 + h]; }
}
__device__ __forceinline__ void wy_build1(const Args& a, LAS unsigned char* slot, const LAS unsigned char* stg, int h, int c, int lane, const float (&dec)[WY_T], const float (&alr)[WY_T], const float (&rn)[WY_T]) {
    const int ch = h * 64 + lane;
    const float mixr = ((const float*)a.in[16])[ch], mixk = ((const float*)a.in[16])[512 + ch], mixv = ((const float*)a.in[16])[1024 + ch];
    const float k_k = ((const float*)a.in[22])[ch], k_a = ((const float*)a.in[23])[ch];
    float bv[WY_T], kv[WY_T], Pt[WY_T], vx[WY_T];
    const LAS unsigned short* sg = (const LAS unsigned short*)stg + lane;
    float pr = bf2f(sg[0]), pk = bf2f(sg[64]), pvv = bf2f(sg[128]);
    if (c == 0) { pr = 0.f; pk = 0.f; pvv = 0.f; }
    float Pcum = 1.f;
    LAS unsigned char* scr = slot + WY_SCR;
    const int po0 = wy_perm_off(0, lane);
#pragma unroll
    for (int t = 0; t < WY_T; t += 2) {
        const f32x2 cr = {bf2f(sg[(3 * (t + 1)) * 64]), bf2f(sg[(3 * (t + 2)) * 64])}, ck = {bf2f(sg[(3 * (t + 1) + 1) * 64]), bf2f(sg[(3 * (t + 2) + 1) * 64])}, cv = {bf2f(sg[(3 * (t + 1) + 2) * 64]), bf2f(sg[(3 * (t + 2) + 2) * 64])};
        const f32x2 prv = {pr, cr.x}, pkv = {pk, ck.x}, pvw = {pvv, cv.x};
        const f32x2 w = {dec[t], dec[t + 1]}, al = {alr[t], alr[t + 1]}, rnv = {rn[t], rn[t + 1]};
        const f32x2 r = cr + (prv - cr) * mixr, kx = ck + (pkv - ck) * mixk, vxx = cv + (pvw - cv) * mixv; pr = cr.y; pk = ck.y; pvv = cv.y;
        vx[t] = vxx.x; vx[t + 1] = vxx.y;
        const f32x2 kkn = kx * k_k * rnv, bvv = kkn * al, kvv = kx * ((al - 1.f) * k_a + 1.f);
        bv[t] = bvv.x; bv[t + 1] = bvv.y; kv[t] = kvv.x; kv[t + 1] = kvv.y;
        const float P0 = Pcum * w.x, P1 = P0 * w.y; const f32x2 Pprev = {Pcum, P0}, Pc = {P0, P1}; Pcum = P1;
        f32x2 invP; invP.x = __builtin_amdgcn_rcpf(P0); invP.y = __builtin_amdgcn_rcpf(P1); Pt[t] = invP.x; Pt[t + 1] = invP.y;
        const f32x2 az = -(kkn * Pprev), ay = r * Pc, bt = bvv * invP, kt2 = kvv * invP;
        const unsigned waz = pk2(az.x, az.y), way = pk2(ay.x, ay.y), wbt = pk2(bt.x, bt.y), wkt = pk2(kt2.x, kt2.y);
        const int po = po0 + t * 64;
        *(LAS unsigned short*)(slot + WY_AZ + po) = (unsigned short)waz; *(LAS unsigned short*)(slot + WY_AZ + po + 64) = (unsigned short)(waz >> 16);
        *(LAS unsigned short*)(slot + WY_AY1 + po) = (unsigned short)way; *(LAS unsigned short*)(slot + WY_AY1 + po + 64) = (unsigned short)(way >> 16);
        *(LAS unsigned short*)(scr + po) = (unsigned short)wbt; *(LAS unsigned short*)(scr + po + 64) = (unsigned short)(wbt >> 16);
        *(LAS unsigned short*)(scr + 2048 + po) = (unsigned short)wkt; *(LAS unsigned short*)(scr + 2048 + po + 64) = (unsigned short)(wkt >> 16);
    }
    { u32x4 w0, w1; w0.x = pk2(vx[0], vx[1]); w0.y = pk2(vx[2], vx[3]); w0.z = pk2(vx[4], vx[5]); w0.w = pk2(vx[6], vx[7]); w1.x = pk2(vx[8], vx[9]); w1.y = pk2(vx[10], vx[11]); w1.z = pk2(vx[12], vx[13]); w1.w = pk2(vx[14], vx[15]);
      *(LAS u32x4*)(slot + WY_VT + lane * 32) = w0; *(LAS u32x4*)(slot + WY_VT + lane * 32 + 16) = w1; }
    *(LAS float*)(slot + WY_PT + lane * 4) = Pcum;
#pragma unroll
    for (int g = 0; g < 4; ++g) { float bh4[4], kh4[4];
#pragma unroll
        for (int j = 0; j < 4; ++j) { const float sc = Pcum * Pt[4 * g + j]; bh4[j] = bv[4 * g + j] * sc; kh4[j] = kv[4 * g + j] * sc; }
        u32x4 w; w.x = pk2(bh4[0], bh4[1]); w.y = pk2(bh4[2], bh4[3]); w.z = pk2(kh4[0], kh4[1]); w.w = pk2(kh4[2], kh4[3]);
        *(LAS u32x4*)(slot + WY_AS + (lane >> 4) * 1024 + (lane & 15) * 64 + g * 16) = w; }
}
__device__ __forceinline__ void wy_build2(LAS unsigned char* slot, int lane) {
    LAS unsigned char* scr = slot + WY_SCR;
    const int row = lane & 15, g = lane >> 4; const int fo = row * 64 + g * 16;
    f32x4 m1 = {0.f, 0.f, 0.f, 0.f}, m2 = m1, m3 = m1, m4 = m1;
#pragma unroll
    for (int s = 0; s < 2; ++s) { const bf16x8 fa = *(const LAS bf16x8*)(slot + WY_AZ + s * 1024 + fo), fr = *(const LAS bf16x8*)(slot + WY_AY1 + s * 1024 + fo), fb = *(const LAS bf16x8*)(scr + s * 1024 + fo), fk = *(const LAS bf16x8*)(scr + 2048 + s * 1024 + fo);
        m1 = __builtin_amdgcn_mfma_f32_16x16x32_bf16(fa, fb, m1, 0, 0, 0); m2 = __builtin_amdgcn_mfma_f32_16x16x32_bf16(fa, fk, m2, 0, 0, 0);
        m3 = __builtin_amdgcn_mfma_f32_16x16x32_bf16(fr, fb, m3, 0, 0, 0); m4 = __builtin_amdgcn_mfma_f32_16x16x32_bf16(fr, fk, m4, 0, 0, 0); }
    WY_FENCE();
#pragma unroll
    for (int i = 0; i < 4; ++i) { const int t = 4 * g + i; const bool lo = row < t, le = row <= t;
        *(LAS float*)(scr + (t * 16 + row) * 4) = lo ? m1[i] : 0.f; *(LAS float*)(scr + 1024 + (t * 16 + row) * 4) = lo ? m2[i] : 0.f;
        *(LAS float*)(scr + 2048 + (t * 16 + row) * 4) = le ? m3[i] : 0.f; *(LAS float*)(scr + 3072 + (t * 16 + row) * 4) = le ? m4[i] : 0.f; }
    WY_FENCE();
    { float x[WY_T];
#pragma unroll
      for (int t = 0; t < WY_T; ++t) x[t] = (t == row) ? 1.f : 0.f;
#pragma unroll
      for (int t = 1; t < WY_T; ++t) { float acc = x[t];
#pragma unroll
          for (int s4 = 0; s4 < (t + 3) / 4; ++s4) { const f32x4 mr = *(const LAS f32x4*)(scr + (t * 16 + 4 * s4) * 4);
#pragma unroll
              for (int e = 0; e < 4; ++e) if (4 * s4 + e < t) acc += mr[e] * x[4 * s4 + e]; }
          x[t] = acc; }
      if (lane < 16) {
#pragma unroll
          for (int t = 0; t < WY_T; ++t) *(LAS float*)(scr + 4096 + (t * 16 + row) * 4) = x[t]; } }
    WY_FENCE();
    { const int t = lane >> 2, gq = lane & 3; f32x4 tm = {0.f, 0.f, 0.f, 0.f};
#pragma unroll
      for (int s4 = 0; s4 < 4; ++s4) { const f32x4 ti = *(const LAS f32x4*)(scr + 4096 + (t * 16 + 4 * s4) * 4);
#pragma unroll
          for (int e = 0; e < 4; ++e) { const f32x4 mr = *(const LAS f32x4*)(scr + 1024 + ((4 * s4 + e) * 16 + 4 * gq) * 4); tm += mr * ti[e]; } }
      const f32x4 ti4 = *(const LAS f32x4*)(scr + 4096 + (t * 16 + 4 * gq) * 4), m34 = *(const LAS f32x4*)(scr + 2048 + (t * 16 + 4 * gq) * 4), m44 = *(const LAS f32x4*)(scr + 3072 + (t * 16 + 4 * gq) * 4);
      u32x4 w; w.x = pk2(ti4.x, ti4.y); w.y = pk2(ti4.z, ti4.w); w.z = pk2(tm.x, tm.y); w.w = pk2(tm.z, tm.w); *(LAS u32x4*)(slot + WY_AU + t * 64 + gq * 16) = w;
      w.x = pk2(m34.x, m34.y); w.y = pk2(m34.z, m34.w); w.z = pk2(m44.x, m44.y); w.w = pk2(m44.z, m44.w); *(LAS u32x4*)(slot + WY_AY2 + t * 64 + gq * 16) = w; }
    WY_FENCE();
}
__device__ __forceinline__ void rw_wy(const Args& a, LAS unsigned char* lds, int bh, int tid) {
    const int b = bh >> 3, h = bh & 7, wave = __builtin_amdgcn_readfirstlane(tid >> 6), lane = tid & 63;
    LAS int* flags = (LAS int*)(lds + WY_FLAGS);
    static_assert(WY_STG + WY_NP * WY_STGSZ <= LDS_BYTES - 32, "WY LDS map");
    if (tid < 16) flags[tid] = (tid == 8 || tid == 9) ? 1 : 0;
    f32x4 ST[2][4];
    { LAS float* blk = (LAS float*)lds;
      if (wave == 2) rw_prep(a, blk, b, h, 0, lane); else if (wave == 3) rw_prep(a, blk + 8 * RW_VEC, b, h, 8, lane);
      asm volatile("s_waitcnt lgkmcnt(0)" ::: "memory");
      __syncthreads();
      if (wave < 2) { const int vl = lane & 15, g = lane >> 4; float* YB0 = (float*)(a.ws + WS_YB);
#pragma unroll
          for (int vt = 0; vt < 2; ++vt)
#pragma unroll
              for (int n = 0; n < 4; ++n) ST[vt][n] = (f32x4){0.f, 0.f, 0.f, 0.f};
#pragma unroll 1
          for (int tt = 0; tt < WY_T; ++tt) { const LAS float* vb = blk + tt * RW_VEC + 4 * g; f32x4 kk4[4], w4[4], bb4[4], kv4[4], r4[4];
#pragma unroll
              for (int n = 0; n < 4; ++n) { w4[n] = *(const LAS f32x4*)(vb + 16 * n); kk4[n] = *(const LAS f32x4*)(vb + 64 + 16 * n); bb4[n] = *(const LAS f32x4*)(vb + 128 + 16 * n); kv4[n] = *(const LAS f32x4*)(vb + 192 + 16 * n); r4[n] = *(const LAS f32x4*)(vb + 256 + 16 * n); }
#pragma unroll
              for (int vt = 0; vt < 2; ++vt) { const int v = 32 * wave + 16 * vt + vl; const float vv = blk[tt * RW_VEC + 320 + v];
                  f32x4 dv = ST[vt][0] * kk4[0] + ST[vt][1] * kk4[1] + ST[vt][2] * kk4[2] + ST[vt][3] * kk4[3]; float dd = (dv.x + dv.y) + (dv.z + dv.w);
                  dd += __shfl_xor(dd, 16); dd += __shfl_xor(dd, 32); const float sa = -dd;
                  f32x4 yv = {0.f, 0.f, 0.f, 0.f};
#pragma unroll
                  for (int n = 0; n < 4; ++n) { ST[vt][n] = ST[vt][n] * w4[n] + (kv4[n] * vv + bb4[n] * sa); yv += ST[vt][n] * r4[n]; }
                  float y = (yv.x + yv.y) + (yv.z + yv.w); y += __shfl_xor(y, 16); y += __shfl_xor(y, 32);
                  if (g == 0) YB0[((size_t)b * SEQ + tt) * 512 + h * 64 + v] = y; } } }
      __syncthreads(); }
    if (wave >= 2) {
        const int p = wave - 2; LAS unsigned char* slot = lds + p * WY_SLOT; LAS unsigned char* stg = lds + WY_STG + p * WY_STGSZ;
        float dec[WY_T], alr[WY_T], rn[WY_T];
        const int c_first = (p == 0) ? WY_NP : p;
        wy_issue(a, stg, b, h, c_first, lane, dec, alr, rn);
        for (int c = c_first; c < WY_NCH; c += WY_NP) {
            while (min(__hip_atomic_load(flags + 8, __ATOMIC_ACQUIRE, __HIP_MEMORY_SCOPE_WORKGROUP), __hip_atomic_load(flags + 9, __ATOMIC_ACQUIRE, __HIP_MEMORY_SCOPE_WORKGROUP)) < c - (WY_NP - 1)) __builtin_amdgcn_s_sleep(2);
            asm volatile("s_waitcnt vmcnt(0)" ::: "memory"); __builtin_amdgcn_wave_barrier();
            wy_build1(a, slot, stg, h, c, lane, dec, alr, rn);
            WY_FENCE();
            if (c + WY_NP < WY_NCH) wy_issue(a, stg, b, h, c + WY_NP, lane, dec, alr, rn);
            wy_build2(slot, lane);
            if (lane == 0) __hip_atomic_store(flags + p, c + 1, __ATOMIC_RELEASE, __HIP_MEMORY_SCOPE_WORKGROUP);
        }
    } else {
        float* YB = (float*)(a.ws + WS_YB);
        const int vl = lane & 15, g = lane >> 4;
        const f32x4 zero4 = {0.f, 0.f, 0.f, 0.f};
        for (int c = 1; c < WY_NCH; ++c) { const int p = c % WY_NP; const LAS unsigned char* slot = lds + p * WY_SLOT;
            while (__hip_atomic_load(flags + p, __ATOMIC_ACQUIRE, __HIP_MEMORY_SCOPE_WORKGROUP) != c + 1) __builtin_amdgcn_s_sleep(1);
            const int fo = vl * 64 + g * 16;
            f32x4 PT4[4];
#pragma unroll
            for (int n = 0; n < 4; ++n) PT4[n] = *(const LAS f32x4*)(slot + WY_PT + (16 * n + 4 * g) * 4);
            const bf16x8 az0 = *(const LAS bf16x8*)(slot + WY_AZ + fo), az1 = *(const LAS bf16x8*)(slot + WY_AZ + 1024 + fo), ay0 = *(const LAS bf16x8*)(slot + WY_AY1 + fo), ay1 = *(const LAS bf16x8*)(slot + WY_AY1 + 1024 + fo);
            const bf16x8 au = *(const LAS bf16x8*)(slot + WY_AU + fo), ay2 = *(const LAS bf16x8*)(slot + WY_AY2 + fo);
            const size_t tokg = (size_t)b * SEQ + (size_t)c * WY_T + 4 * g;
#pragma unroll
            for (int vt = 0; vt < 2; ++vt) { const int v = 32 * wave + 16 * vt + vl;
                u32x4 s0w, s1w; s0w.x = pk2(ST[vt][0].x, ST[vt][0].y); s0w.y = pk2(ST[vt][0].z, ST[vt][0].w); s0w.z = pk2(ST[vt][1].x, ST[vt][1].y); s0w.w = pk2(ST[vt][1].z, ST[vt][1].w);
                s1w.x = pk2(ST[vt][2].x, ST[vt][2].y); s1w.y = pk2(ST[vt][2].z, ST[vt][2].w); s1w.z = pk2(ST[vt][3].x, ST[vt][3].y); s1w.w = pk2(ST[vt][3].z, ST[vt][3].w);
                const bf16x8 sf0 = __builtin_bit_cast(bf16x8, s0w), sf1 = __builtin_bit_cast(bf16x8, s1w);
                f32x4 z = __builtin_amdgcn_mfma_f32_16x16x32_bf16(az0, sf0, zero4, 0, 0, 0); z = __builtin_amdgcn_mfma_f32_16x16x32_bf16(az1, sf1, z, 0, 0, 0);
                const u32x2 vq = *(const LAS u32x2*)(slot + WY_VT + v * 32 + g * 8);
                u32x4 f1w; f1w.x = pk2(z.x, z.y); f1w.y = pk2(z.z, z.w); f1w.z = vq.x; f1w.w = vq.y;
                const f32x4 u = __builtin_amdgcn_mfma_f32_16x16x32_bf16(au, __builtin_bit_cast(bf16x8, f1w), zero4, 0, 0, 0);
                u32x4 f2w; f2w.x = pk2(u.x, u.y); f2w.y = pk2(u.z, u.w); f2w.z = vq.x; f2w.w = vq.y; const bf16x8 f2 = __builtin_bit_cast(bf16x8, f2w);
                f32x4 y = __builtin_amdgcn_mfma_f32_16x16x32_bf16(ay0, sf0, zero4, 0, 0, 0); y = __builtin_amdgcn_mfma_f32_16x16x32_bf16(ay1, sf1, y, 0, 0, 0); y = __builtin_amdgcn_mfma_f32_16x16x32_bf16(ay2, f2, y, 0, 0, 0);
#pragma unroll
                for (int i = 0; i < 4; ++i) YB[(tokg + i) * 512 + h * 64 + v] = y[i];
#pragma unroll
                for (int n = 0; n < 4; ++n) { const bf16x8 as = *(const LAS bf16x8*)(slot + WY_AS + n * 1024 + fo); ST[vt][n] = __builtin_amdgcn_mfma_f32_16x16x32_bf16(as, f2, ST[vt][n] * PT4[n], 0, 0, 0); }
            }
            asm volatile("s_waitcnt lgkmcnt(0)" ::: "memory");
            if (lane == 0) __hip_atomic_store(flags + 8 + wave, c + 1, __ATOMIC_RELEASE, __HIP_MEMORY_SCOPE_WORKGROUP);
        }
    }
    __syncthreads();
}
struct PostIn { u32x4 ya, gate, vc, vp, rc, rp, kc, kp, al; f32x4 y0, y1; };
__device__ __forceinline__ void mixpost_load(PostIn& m, const bf16* YC, const float* YB, const bf16* PR, const bf16* AL, int row, int lane) {
    m.ya = *(const u32x4*)(YC + (size_t)row * DM + 8 * lane); m.gate = *(const u32x4*)(YC + (size_t)row * DM + 512 + 8 * lane);
    m.y0 = *(const f32x4*)(YB + (size_t)row * 512 + 8 * lane); m.y1 = *(const f32x4*)(YB + (size_t)row * 512 + 8 * lane + 4);
    const bool hp = (row & (SEQ - 1)) != 0; const size_t rp = hp ? (size_t)(row - 1) : (size_t)row;
    m.rc = *(const u32x4*)(PR + (size_t)row * 1792 + 8 * lane); m.kc = *(const u32x4*)(PR + (size_t)row * 1792 + 512 + 8 * lane); m.vc = *(const u32x4*)(PR + (size_t)row * 1792 + 1024 + 8 * lane);
    m.rp = *(const u32x4*)(PR + rp * 1792 + 8 * lane); m.kp = *(const u32x4*)(PR + rp * 1792 + 512 + 8 * lane); m.vp = *(const u32x4*)(PR + rp * 1792 + 1024 + 8 * lane);
    if (!hp) { m.rp = (u32x4){0u, 0u, 0u, 0u}; m.kp = m.rp; m.vp = m.rp; }
    m.al = *(const u32x4*)(AL + (size_t)row * 512 + 8 * lane);
}
__device__ __forceinline__ void mixpost_compute(const PostIn& m, const Args& a, bf16* YC, int row, int lane) {
    const float* ga = (const float*)a.in[15] + 8 * lane; const float* lw = (const float*)a.in[25] + 8 * lane; const float* lb = (const float*)a.in[26] + 8 * lane;
    const float* mr = (const float*)a.in[16] + 8 * lane; const float* mk = mr + 512; const float* mv = mr + 1024; const float* kap = (const float*)a.in[23] + 8 * lane; const float* rkp = (const float*)a.in[24] + 8 * lane;
    float f[8]; unpack8(m.ya, f); float s = 0.f;
#pragma unroll
    for (int e = 0; e < 8; ++e) s += f[e] * f[e];
    const float y[8] = {m.y0.x, m.y0.y, m.y0.z, m.y0.w, m.y1.x, m.y1.y, m.y1.z, m.y1.w}; float s1 = 0.f, s2 = 0.f;
#pragma unroll
    for (int e = 0; e < 8; ++e) { s1 += y[e]; s2 += y[e] * y[e]; }
    float rc[8], rp[8], kc[8], kp[8], al[8], vc[8], vp[8], gg[8]; unpack8(m.rc, rc); unpack8(m.rp, rp); unpack8(m.kc, kc); unpack8(m.kp, kp); unpack8(m.al, al); unpack8(m.vc, vc); unpack8(m.vp, vp); unpack8(m.gate, gg);
    float cs = 0.f;
#pragma unroll
    for (int e = 0; e < 8; ++e) { const float r = rc[e] + (rp[e] - rc[e]) * mr[e], kx = kc[e] + (kp[e] - kc[e]) * mk[e]; cs += r * kx * (1.f + (al[e] - 1.f) * kap[e]) * rkp[e]; }
#pragma unroll
    for (int o = 1; o < 64; o <<= 1) { s += __shfl_xor(s, o); if (o < 8) { s1 += __shfl_xor(s1, o); s2 += __shfl_xor(s2, o); cs += __shfl_xor(cs, o); } }
    const float rinv = rsqrtf(s * (1.f / 512.f) + 1e-6f);
    { u32x4 o; o.x = pk2(f[0] * rinv * ga[0], f[1] * rinv * ga[1]); o.y = pk2(f[2] * rinv * ga[2], f[3] * rinv * ga[3]); o.z = pk2(f[4] * rinv * ga[4], f[5] * rinv * ga[5]); o.w = pk2(f[6] * rinv * ga[6], f[7] * rinv * ga[7]); *(u32x4*)(YC + (size_t)row * DM + 8 * lane) = o; }
    const float mean = s1 * (1.f / 64.f), var = fmaxf(s2 * (1.f / 64.f) - mean * mean, 0.f), rstd = rsqrtf(var + 64e-5f);
    float o[8];
#pragma unroll
    for (int e = 0; e < 8; ++e) { const float v = vc[e] + (vp[e] - vc[e]) * mv[e]; o[e] = ((y[e] - mean) * rstd * lw[e] + lb[e] + cs * v) * gg[e]; }
    u32x4 w; w.x = pk2(o[0], o[1]); w.y = pk2(o[2], o[3]); w.z = pk2(o[4], o[5]); w.w = pk2(o[6], o[7]); *(u32x4*)(YC + (size_t)row * DM + 512 + 8 * lane) = w;
}
__device__ __forceinline__ void phase_mixpost(const Args& a, int lane, int gw, int NGW) {
    unsigned char* ws = a.ws; bf16* YC = (bf16*)(ws + WS_U); const float* YB = (const float*)(ws + WS_YB); const bf16* PR = (const bf16*)(ws + WS_PRW); const bf16* AL = (const bf16*)(ws + WS_AL);
    for (int row = gw; row < MT; row += 2 * NGW) { const int row2 = row + NGW; const bool has2 = row2 < MT;
        PostIn A, B; mixpost_load(A, YC, YB, PR, AL, row, lane); mixpost_load(B, YC, YB, PR, AL, has2 ? row2 : row, lane);
        mixpost_compute(A, a, YC, row, lane); if (has2) mixpost_compute(B, a, YC, row2, lane); }
}
#define XB_TMO      128
#define XB_XCNT(j)  (256  + 64 * (j))
#define XB_XSUB(j)  (1280 + 64 * (j))
#define XB_XGEN(j)  (2304 + 64 * (j))
#define XB_TOP      3328
#define XB_TOPGEN   3392
#define XCD_BAR_WORDS 3456
#define XB_SPIN_CAP (1u << 18)

__device__ __forceinline__ unsigned xb_ld(unsigned* p)              { return __hip_atomic_load(p, __ATOMIC_RELAXED, __HIP_MEMORY_SCOPE_AGENT); }
__device__ __forceinline__ unsigned xb_add(unsigned* p, unsigned v) { return __hip_atomic_fetch_add(p, v, __ATOMIC_RELAXED, __HIP_MEMORY_SCOPE_AGENT); }
__device__ __forceinline__ unsigned xb_xcc_id() { return (unsigned)__builtin_amdgcn_s_getreg((3 << 11) | 20) & 0xFu; }
#define XB_SPIN(cond, bar) do { unsigned _sp = 0; while (cond) { __builtin_amdgcn_s_sleep(1); \
    if ((++_sp & 255u) == 0u) { if (xb_ld(&(bar)[XB_TMO])) break; if (_sp > XB_SPIN_CAP) { atomicAdd(&(bar)[XB_TMO], 1u); break; } } } } while (0)

struct XcdBarrier {
    unsigned* bar; unsigned x;
    volatile LAS unsigned* st;
};

__device__ __forceinline__ XcdBarrier xcd_barrier_post(unsigned* bar, volatile LAS unsigned* st) {
    XcdBarrier b; b.bar = bar; b.x = xb_xcc_id(); b.st = st;
    if (threadIdx.x == 0) (void)xb_add(&bar[XB_XCNT(b.x)], 1u);
    return b;
}
__device__ __forceinline__ void xcd_barrier_complete(unsigned* bar, unsigned x, unsigned& nloc, unsigned& nx) {
    const unsigned G = gridDim.x * gridDim.y * gridDim.z;
    unsigned sum, cnt, mine, sp = 0u;
    for (;;) {
        sum = 0u; cnt = 0u; mine = 0u;
#pragma unroll
        for (unsigned j = 0; j < 16; ++j) { const unsigned c = xb_ld(&bar[XB_XCNT(j)]); sum += c; cnt += (c > 0u) ? 1u : 0u; mine = (j == x) ? c : mine; }
        if (sum == G) break;
        __builtin_amdgcn_s_sleep(1);
        if ((++sp & 255u) == 0u) { if (xb_ld(&bar[XB_TMO])) break; if (sp > XB_SPIN_CAP) { atomicAdd(&bar[XB_TMO], 1u); break; } }
    }
    nloc = mine > 0u ? mine : 1u; nx = cnt > 0u ? cnt : 1u;
}

__device__ __forceinline__ void xcd_barrier(const XcdBarrier& b) {
    asm volatile("s_waitcnt vmcnt(0)" ::: "memory");
    __syncthreads();
    if (threadIdx.x == 0) {
        unsigned* bar = b.bar;
        __builtin_amdgcn_s_waitcnt(0);
        unsigned nloc = b.st[0], nx = b.st[1];
        if (nloc == 0u) { xcd_barrier_complete(bar, b.x, nloc, nx); b.st[0] = nloc; b.st[1] = nx; }
        const unsigned old = xb_add(&bar[XB_XSUB(b.x)], 1u);
        const unsigned gen = old / nloc;
        if (old + 1u == (gen + 1u) * nloc) {
            __builtin_amdgcn_fence(__ATOMIC_RELEASE, "agent");
            asm volatile("s_waitcnt vmcnt(0)" ::: "memory");
            const unsigned og = xb_add(&bar[XB_TOP], 1u);
            const unsigned tg = og / nx;
            if (og + 1u == (tg + 1u) * nx) xb_add(&bar[XB_TOPGEN], 1u);
            else XB_SPIN(xb_ld(&bar[XB_TOPGEN]) == tg, bar);
            __builtin_amdgcn_fence(__ATOMIC_ACQUIRE, "agent");
            xb_add(&bar[XB_XGEN(b.x)], 1u);
            asm volatile("s_waitcnt vmcnt(0)" ::: "memory");
        } else {
            XB_SPIN(xb_ld(&bar[XB_XGEN(b.x)]) == gen, bar);
            __builtin_amdgcn_fence(__ATOMIC_ACQUIRE, "agent");
            asm volatile("s_waitcnt vmcnt(0)" ::: "memory");
        }
    }
    __syncthreads();
}

__global__ void __launch_bounds__(512, 2) mk_fwd(Args a) {
    extern __shared__ __attribute__((aligned(16))) unsigned char lds_raw[];
    LAS unsigned char* lds = (LAS unsigned char*)lds_raw;
    cg::grid_group grid = cg::this_grid();
    int tid = threadIdx.x, lane = tid & 63, wave = __builtin_amdgcn_readfirstlane(tid >> 6);
    const int G = gridDim.x; int gw = blockIdx.x * 8 + wave; const int NGW = G * 8;
#define RELAUNDER() do { tid = threadIdx.x; asm volatile("" : "+v"(tid)); lane = tid & 63; wave = __builtin_amdgcn_readfirstlane(tid >> 6); gw = blockIdx.x * 8 + wave; } while (0)
    unsigned char* ws = a.ws;
    const float* x = (const float*)a.in[0]; float* hbuf = a.out;
    const float* MOD = (const float*)(ws + WS_MOD);
    bf16* U = (bf16*)(ws + WS_U); bf16* ACT = (bf16*)(ws + WS_ACT);
    using pg8::Gemm; using pg8::StaticOrder;

#ifndef ONLY
#define ONLY -1
#endif
#define PH(n) (ONLY < 0 || ONLY == (n))
#ifndef SKIPMASK
#define SKIPMASK 0
#endif
#ifndef DUP
#define DUP -1
#endif
#define REP(n) for (int rep_ = 0; rep_ < ((DUP == (n)) ? 2 : 1); ++rep_)
    unsigned* barw = (unsigned*)(ws + WS_BAR);
    if (blockIdx.x == 0) for (int i = threadIdx.x; i < XCD_BAR_WORDS; i += 512) barw[i] = 0u;
    volatile LAS unsigned* bst = (volatile LAS unsigned*)(lds + LDS_BYTES - 32);
    if (threadIdx.x < 2) bst[threadIdx.x] = 0u;
    __syncthreads();
    if (PH(0)) REP(0) {
    if (blockIdx.x == 0 && threadIdx.x < 8) *((unsigned*)(a.ws + WS_CTR) + 16 * threadIdx.x) = 0u;
    phase_prologue(a, lds, tid, lane, wave); }
    grid.sync(); RELAUNDER();
    XcdBarrier xbar = xcd_barrier_post(barw, bst);
#if DUP == 99
    for (int i_ = 0; i_ < 16; ++i_) xcd_barrier(xbar);
#endif
    if (PH(1)) REP(1)
    phase_normmod(x, (const float*)a.in[5], MOD, 0, 1024, U, lane, gw, NGW);
    xcd_barrier(xbar); RELAUNDER();
    if (PH(2))
    REP(2)
    { Gemm g{U, (const bf16*)(ws + WS_WGU1), MT, 2 * FF, DM}; StaticOrder S; S.init(MT, 2 * FF, G, (int)blockIdx.x); pg8::EpiSwiglu E{ACT, FF};
      pg8::gemm_phase<pg8::EpiSwiglu, StaticOrder, true, true>(lds, g, S, E); }
    xcd_barrier(xbar); RELAUNDER();
    if (PH(3)) REP(3)
    { Gemm g{ACT, (const bf16*)(ws + WS_WD1), MT, DM, FF}; StaticOrder S; S.init(MT, DM, G, (int)blockIdx.x); pg8::EpiResid E{x, hbuf, MOD + 2048, 0.5f};
      pg8::gemm_phase<pg8::EpiResid, StaticOrder, true, true>(lds, g, S, E); }
    xcd_barrier(xbar); RELAUNDER();
    if (PH(1))
    phase_normmod(hbuf, (const float*)a.in[9], MOD, 3072, 4096, U, lane, gw, NGW);
    xcd_barrier(xbar); RELAUNDER();
    if (PH(5)) REP(5)
    { Gemm g{U, (const bf16*)(ws + WS_WIN), MT, 2560, DM}; StaticOrder S; S.init(MT, 2560, G, (int)blockIdx.x); pg8::EpiProj E{(bf16*)(ws + WS_PMLA), (bf16*)(ws + WS_PRW)};
      pg8::gemm_phase<pg8::EpiProj, StaticOrder, true, true>(lds, g, S, E); }
    xcd_barrier(xbar); RELAUNDER();
    if (PH(6)) REP(6)
    phase_mixprep(a, lane, gw, NGW);
    xcd_barrier(xbar); RELAUNDER();
    {
    if (PH(7)) REP(71)
    { Gemm g{(const bf16*)(ws + WS_QN), (const bf16*)(ws + WS_WUQ), MT, 768, 384 + (G >> 20)}; StaticOrder S; S.init(MT, 768, G, (int)blockIdx.x); pg8::EpiQ E{(bf16*)(ws + WS_QB), (const float*)(ws + WS_CS), 0.07216878364870322f * 1.4426950408889634f};
      pg8::gemm_phase<pg8::EpiQ, StaticOrder, true, true>(lds, g, S, E); }
    if (PH(8)) REP(72)
    { Gemm g{(const bf16*)(ws + WS_KVN), (const bf16*)(ws + WS_WK), MT, 512, 256 + (G >> 20)}; StaticOrder S; S.init(MT, 512, G, (int)blockIdx.x); pg8::EpiPlain E{(bf16*)(ws + WS_KN), 512};
      pg8::gemm_phase<pg8::EpiPlain, StaticOrder, true, true>(lds, g, S, E); }
    if (PH(9)) REP(73)
    { Gemm g{(const bf16*)(ws + WS_WV), (const bf16*)(ws + WS_KVN), 512, MT, 256 + (G >> 20)}; StaticOrder S; S.init(512, MT, G, (int)blockIdx.x); pg8::EpiVT E{(bf16*)(ws + WS_VT), (size_t)MT};
      pg8::gemm_phase<pg8::EpiVT, StaticOrder, true, true>(lds, g, S, E); }
    if (PH(10)) REP(74)
    { Gemm g{(const bf16*)(ws + WS_LIN), (const bf16*)(ws + WS_WLORA), MT, 1536, 256 + (G >> 20)}; StaticOrder S; S.init(MT, 1536, G, (int)blockIdx.x); pg8::EpiLora E{(float*)(ws + WS_DEC), (bf16*)(ws + WS_AL), U, (const float*)a.in[17], (const float*)a.in[19]};
      pg8::gemm_phase<pg8::EpiLora, StaticOrder, true, true>(lds, g, S, E); }
    }
    xcd_barrier(xbar); RELAUNDER();
    if (PH(11)) REP(30) {
        unsigned* qctr = (unsigned*)(ws + WS_CTR) + 64 * rep_;
        REP(21)
        for (int bh = blockIdx.x; bh < 64; bh += G) { rw_wy(a, lds, bh, tid); }
        volatile LAS unsigned* qslot = (volatile LAS unsigned*)(lds + LDS_BYTES - 16);
        const unsigned myq = xb_xcc_id() & 7u;
        for (;;) {
            if (tid == 0) { unsigned code = 0xffffffffu;
                for (unsigned s = 0; s < 8u; ++s) { const unsigned q = (myq + s) & 7u; const unsigned idx = atomicAdd(qctr + 16 * q, 1u); if (idx < 128u) { code = q * 128u + idx; break; } }
                *qslot = code; }
            __syncthreads();
            const unsigned code = *qslot;
            if (code == 0xffffffffu) break;
            const unsigned q = code >> 7, idx = code & 127u;
            const int u = 31 - (int)(idx & 31u), bh = (int)(4u * q + (idx >> 5));
            attn_unit((const bf16*)(ws + WS_QB), (const bf16*)(ws + WS_KN), (const bf16*)(ws + WS_KR), (const bf16*)(ws + WS_VT), U, lds, bh >> 2, bh & 3, u, tid, lane, wave);
        }
    }
    xcd_barrier(xbar); RELAUNDER();
    if (PH(13)) phase_mixpost(a, lane, gw, NGW);
    xcd_barrier(xbar); RELAUNDER();
    if (PH(3))
    { Gemm g{U, (const bf16*)(ws + WS_WOUT), MT, DM, DM}; StaticOrder S; S.init(MT, DM, G, (int)blockIdx.x); pg8::EpiResid E{hbuf, hbuf, MOD + 5120, 1.0f};
      pg8::gemm_phase<pg8::EpiResid, StaticOrder, true, true>(lds, g, S, E); }
    xcd_barrier(xbar); RELAUNDER();
    if (PH(1))
    phase_normmod(hbuf, (const float*)a.in[28], MOD, 6144, 7168, U, lane, gw, NGW);
    xcd_barrier(xbar); RELAUNDER();
    if (PH(2))
    { Gemm g{U, (const bf16*)(ws + WS_WGU2), MT, 2 * FF, DM}; StaticOrder S; S.init(MT, 2 * FF, G, (int)blockIdx.x); pg8::EpiSwiglu E{ACT, FF};
      pg8::gemm_phase<pg8::EpiSwiglu, StaticOrder, true, true>(lds, g, S, E); }
    xcd_barrier(xbar); RELAUNDER();
    if (PH(3))
    { Gemm g{ACT, (const bf16*)(ws + WS_WD2), MT, DM, FF}; StaticOrder S; S.init(MT, DM, G, (int)blockIdx.x); pg8::EpiResid E{hbuf, hbuf, MOD + 8192, 0.5f};
      pg8::gemm_phase<pg8::EpiResid, StaticOrder, true, true>(lds, g, S, E); }
    xcd_barrier(xbar); RELAUNDER();
    if (PH(15))
    phase_finalnorm(hbuf, (const float*)a.in[32], lane, gw, NGW);
}

extern "C" void kernel_launch(void* const* d_in, const int* in_sizes, int n_in, void* d_out, int out_size, void* d_ws, size_t ws_size, hipStream_t stream) {
    static int grid = 0;
    if (grid == 0) {
        int dev = 0, cus = 0, per_cu = 0;
        hipGetDevice(&dev); hipDeviceGetAttribute(&cus, hipDeviceAttributeMultiprocessorCount, dev);
        if (hipFuncSetAttribute((const void*)mk_fwd, hipFuncAttributeMaxDynamicSharedMemorySize, LDS_BYTES) != hipSuccess) { fprintf(stderr, "kernel_launch: hipFuncSetAttribute failed\n"); grid = -1; return; }
        if (hipOccupancyMaxActiveBlocksPerMultiprocessor(&per_cu, (const void*)mk_fwd, 512, LDS_BYTES) != hipSuccess || per_cu < 1) { fprintf(stderr, "kernel_launch: occupancy query gave %d\n", per_cu); per_cu = 1; }
        (void)hipGetLastError();
        grid = cus * per_cu;
        if (n_in != 33 || ws_size < (size_t)990 * MiB) { fprintf(stderr, "kernel_launch: unexpected n_in %d / ws %zu\n", n_in, ws_size); grid = -1; return; }
    }
    if (grid < 0) return;
    Args a{};
    for (int i = 0; i < 33; ++i) a.in[i] = d_in[i];
    a.out = (float*)d_out; a.ws = (unsigned char*)d_ws;
    void* args[] = {&a};
    hipError_t e = hipLaunchCooperativeKernel((const void*)mk_fwd, dim3(grid), dim3(512), args, LDS_BYTES, stream);
    if (e != hipSuccess) fprintf(stderr, "cooperative launch failed: %s (grid %d)\n", hipGetErrorString(e), grid);
}
```
